# Optimizing an MI355X kernel written in HIP

```python
import jax, jax.numpy as jnp
from jax import lax
import numpy as np

D_MODEL = 2048
BATCH = 4
SEQ = 2048
DEPTH = 1

N_META = 16
POOL_WIDTH = D_MODEL
POOL_WINDOWS = (2, 4, 8, 16)
N_POOL_GROUPS = len(POOL_WINDOWS)
POOL_GROUP = POOL_WIDTH // N_POOL_GROUPS
CONV_WIDTH = D_MODEL
CONV_K = 3
N_BRANCHES = 2
FFN_HIDDEN = ((8 * D_MODEL // 3 + 255) // 256) * 256
IN_PROJ_WIDTH = POOL_WIDTH + 3 * CONV_WIDTH + N_BRANCHES * D_MODEL
EPS = 1e-6

kernel_name = "hybrid_pool_shortconv_gated_block"


def rms_norm(x, g):
    xf = x.astype(jnp.float32)
    y = xf * lax.rsqrt(jnp.mean(xf * xf, axis=-1, keepdims=True) + EPS)
    return (y * g.astype(jnp.float32)).astype(x.dtype)


def causal_multiscale_pool(u):
    b, l, _ = u.shape
    ug = u.reshape(b, l, N_POOL_GROUPS, POOL_GROUP).astype(jnp.float32)
    c = jnp.concatenate([jnp.zeros((b, 1, N_POOL_GROUPS, POOL_GROUP), jnp.float32),
                         jnp.cumsum(ug, axis=1)], axis=1)
    t1 = jnp.arange(1, l + 1, dtype=jnp.float32)
    outs = []
    for gi, w in enumerate(POOL_WINDOWS):
        cg = c[:, :, gi]
        c_lag = jnp.pad(cg, ((0, 0), (w - 1, 0), (0, 0)))[:, :l]
        win_sum = cg[:, 1:] - c_lag
        count = jnp.minimum(t1, jnp.float32(w))[None, :, None]
        outs.append(win_sum / count - ug[:, :, gi])
    return jnp.stack(outs, axis=2).astype(u.dtype)


def causal_depthwise_conv(v, w):
    l = v.shape[1]
    vp = jnp.pad(v, ((0, 0), (CONV_K - 1, 0), (0, 0)))
    return sum(w[k][None, None, :] * vp[:, k:k + l] for k in range(CONV_K))


def setup_inputs(seed: int = 0) -> dict:
    key = jax.random.key(seed)
    ks = jax.random.split(key, 16)
    f32 = jnp.float32
    nrm = lambda k, shape, scale: jax.random.normal(k, shape, f32) * scale
    return {
        "x": nrm(ks[0], (BATCH, SEQ, D_MODEL), 1.0),
        "meta_tokens": nrm(ks[1], (N_META, D_MODEL), 1.0),
        "norm_mix_g": 1.0 + nrm(ks[2], (D_MODEL,), 0.02),
        "w_in": nrm(ks[3], (D_MODEL, IN_PROJ_WIDTH), D_MODEL ** -0.5),
        "b_gate": nrm(ks[4], (N_BRANCHES * D_MODEL,), 0.02),
        "pool_w": nrm(ks[5], (N_POOL_GROUPS, POOL_GROUP, POOL_GROUP), POOL_GROUP ** -0.5),
        "pool_scale": 1.0 + nrm(ks[6], (POOL_WIDTH,), 0.02),
        "conv_w": nrm(ks[7], (CONV_K, CONV_WIDTH), CONV_K ** -0.5),
        "conv_out_w": nrm(ks[8], (CONV_WIDTH, D_MODEL), CONV_WIDTH ** -0.5),
        "w_o": nrm(ks[9], (D_MODEL, D_MODEL), D_MODEL ** -0.5),
        "norm_ffn_g": 1.0 + nrm(ks[10], (D_MODEL,), 0.02),
        "w_gate_up": nrm(ks[11], (D_MODEL, 2 * FFN_HIDDEN), D_MODEL ** -0.5),
        "w_down": nrm(ks[12], (FFN_HIDDEN, D_MODEL), FFN_HIDDEN ** -0.5),
        "norm_final_g": 1.0 + nrm(ks[13], (D_MODEL,), 0.02),
    }


def reference(x, meta_tokens, norm_mix_g, w_in, b_gate, pool_w, pool_scale, conv_w,
              conv_out_w, w_o, norm_ffn_g, w_gate_up, w_down, norm_final_g):
    b = x.shape[0]
    meta = jnp.broadcast_to(meta_tokens[None].astype(x.dtype), (b, N_META, D_MODEL))
    h = jnp.concatenate([meta, x], axis=1)

    splits = np.cumsum([POOL_WIDTH, CONV_WIDTH, CONV_WIDTH, CONV_WIDTH, D_MODEL]).tolist()
    for _ in range(DEPTH):
        hn = rms_norm(h, norm_mix_g)
        proj = hn @ w_in
        u, gb_in, gc_in, v_in, ga_lin, gbr_lin = jnp.split(proj, splits, axis=-1)

        pooled = causal_multiscale_pool(u)
        y_a = jnp.einsum("blgc,gcd->blgd", pooled, pool_w).reshape(b, -1, POOL_WIDTH)
        y_a = y_a * pool_scale

        y_b = (gb_in * causal_depthwise_conv(gc_in * v_in, conv_w)) @ conv_out_w

        gates = jax.nn.sigmoid(jnp.concatenate([ga_lin, gbr_lin], axis=-1) + b_gate)
        g_a, g_b = jnp.split(gates, 2, axis=-1)
        h = h + (g_a * y_a + g_b * y_b) @ w_o

        hn = rms_norm(h, norm_ffn_g)
        gate, up = jnp.split(hn @ w_gate_up, 2, axis=-1)
        h = h + (jax.nn.silu(gate) * up) @ w_down

    out = rms_norm(h, norm_final_g)
    return out[:, N_META:]
```

```cpp
#include <hip/hip_runtime.h>
#include <hip/hip_cooperative_groups.h>
#include <cstdio>
#include <cstdint>
namespace cg = cooperative_groups;

#define LAS __attribute__((address_space(3)))
typedef unsigned short bf16_t;
typedef short bf16x8 __attribute__((ext_vector_type(8)));
typedef float f32x4 __attribute__((ext_vector_type(4)));
typedef unsigned u32x4 __attribute__((ext_vector_type(4)));

#ifndef MK_N_LAUNCHES
#define MK_N_LAUNCHES 1
#endif
constexpr int N_PHASES = 7;

constexpr int D = 2048, SEQ = 2048, NBATCH = 4, NMETA = 16;
constexpr int MX = NBATCH * SEQ;
constexpr int MA = 33 * 256;
constexpr int NIN = 12288, FF = 5632, NGU = 2 * FF, KCAT = 512 + 2048;
constexpr float EPS = 1e-6f;

constexpr size_t MiB = 1u << 20;
constexpr size_t WS_SSQ1 = 1 * MiB, WS_SSQ2 = 2 * MiB;
constexpr size_t WS_WD = 4 * MiB;
constexpr size_t WS_WGU = 26 * MiB;
constexpr size_t WS_WO = 70 * MiB;
constexpr size_t WS_BCAT = 78 * MiB;
constexpr size_t WS_WIN = 88 * MiB;
constexpr size_t WS_HN = 136 * MiB;
constexpr size_t WS_U = 169 * MiB;
constexpr size_t WS_S = 202 * MiB;
constexpr size_t WS_GB = 235 * MiB;
constexpr size_t WS_GATES = 267 * MiB;
constexpr size_t WS_ACT2 = 88 * MiB;
constexpr size_t WS_ZA = 169 * MiB;
constexpr size_t WS_Z = 235 * MiB;
constexpr size_t WS_H1B = 169 * MiB;
constexpr size_t WS_ACT = 202 * MiB;
constexpr size_t WS_END = 331 * MiB;

constexpr int LDS_BYTES = 131072 + 4096;

#define NT_LD(p) __builtin_nontemporal_load(p)
#define NT_ST(v, p) (*(p) = (v))
__device__ __forceinline__ void st16_wt(void* p, const unsigned __attribute__((ext_vector_type(4))) v) { asm volatile("global_store_dwordx4 %0, %1, off sc1\n\ts_nop 1" :: "v"(p), "v"(v) : "memory"); }
typedef __bf16 bf16x2_t __attribute__((ext_vector_type(2)));
typedef float f32x2_t __attribute__((ext_vector_type(2)));
__device__ __forceinline__ unsigned cvt_pk_bf16(float lo, float hi) { const f32x2_t v = {lo, hi}; return __builtin_bit_cast(unsigned, __builtin_convertvector(v, bf16x2_t)); }
__device__ __forceinline__ float bf_lo(unsigned u) { return __uint_as_float(u << 16); }
__device__ __forceinline__ float bf_hi(unsigned u) { return __uint_as_float(u & 0xffff0000u); }
__device__ __forceinline__ void unpack8(const u32x4 w, float (&f)[8]) { f[0] = bf_lo(w.x); f[1] = bf_hi(w.x); f[2] = bf_lo(w.y); f[3] = bf_hi(w.y); f[4] = bf_lo(w.z); f[5] = bf_hi(w.z); f[6] = bf_lo(w.w); f[7] = bf_hi(w.w); }
__device__ __forceinline__ u32x4 pack8(const f32x4 a, const f32x4 b) { u32x4 w; w.x = cvt_pk_bf16(a[0], a[1]); w.y = cvt_pk_bf16(a[2], a[3]); w.z = cvt_pk_bf16(b[0], b[1]); w.w = cvt_pk_bf16(b[2], b[3]); return w; }
__device__ __forceinline__ float sigmoidf_fast(float x) { return __builtin_amdgcn_rcpf(1.0f + __builtin_amdgcn_exp2f(-1.44269504089f * x)); }
__device__ __forceinline__ float wave_sum(float v) {
#pragma unroll
    for (int o = 1; o < 64; o <<= 1) v += __shfl_xor(v, o);
    return v;
}

namespace pg8 {
constexpr int BM = 256, BK = 64, HALF = 128, HTB = HALF * BK * 2, STAGE_BYTES = 8 * HTB;
__device__ __forceinline__ int lds_byte(int r, int c) { const int st = (r >> 4) * 2 + (c >> 5), rr = r & 15, cc = c & 31, ob = rr * 64 + cc * 2; return st * 1024 + (ob ^ (((ob >> 9) & 1) << 5)); }
__device__ __forceinline__ void stage_rc(int b, int& R, int& C) { const int st = b / 1024, sb = b % 1024, swz = sb ^ (((sb >> 9) & 1) << 5); R = (st >> 1) * 16 + swz / 64; C = (st & 1) * 32 + (swz % 64) / 2; }
__device__ __forceinline__ int perm32(int rho) { const int n = rho >> 4, i = rho & 15; return 8 * (i >> 2) + 4 * n + (i & 3); }

struct Unit { const char* A; const char* B; int nt, kind, pm, pn, seq; };

__device__ __forceinline__ void tile_of(int L, int nM, int nN, int& pm, int& pn) {
    const int nwg = nM * nN; int wgid = L;
    { const int q = nwg / 8, r = nwg % 8, xcd = wgid % 8, off = wgid / 8; wgid = (xcd < r ? xcd * (q + 1) : r * (q + 1) + (xcd - r) * q) + off; }
    constexpr int WGM = 4;
    const int nig = WGM * nN, gid = wgid / nig, fm = gid * WGM, gsz = (nM - fm) < WGM ? (nM - fm) : WGM;
    pm = fm + ((wgid % nig) % gsz); pn = (wgid % nig) / gsz;
}

template <bool HALF_M = false, class Sched, class Epi>
__device__ __forceinline__ void gemm_phase(LAS unsigned char* lds, const int ldA, const int ldB, const Sched& S, const Epi& E) {
    const int tid = threadIdx.x, wid = __builtin_amdgcn_readfirstlane(tid >> 6), lane = tid & 63, wr = wid >> 2, wc = wid & 3, fr = lane & 15, fq = lane >> 4;
    unsigned voffA[2], voffB[2];
#pragma unroll
    for (int i = 0; i < 2; ++i) { int R, C; stage_rc(tid * 16 + i * 8192, R, C); const int Rb = (R & ~31) + perm32(R & 31);
        voffA[i] = (unsigned)(R * ldA + C) * 2u; voffB[i] = (unsigned)(Rb * ldB + C) * 2u; }
    const size_t kstep = (size_t)(BK * 2);
    const size_t hstepA = (size_t)HALF * ldA * 2, hstepB = (size_t)HALF * ldB * 2;
    const unsigned ldsw = (unsigned)wid * 1024u;
    const int aoff = lds_byte(wr * 64 + fr, fq * 8), boff = lds_byte(wc * 32 + fr, fq * 8);
#define PG8_SA(b, h) (((b) * 2 + (h)) * HTB)
#define PG8_SB(b, h) ((4 + (b) * 2 + (h)) * HTB)
#define PG8_STAGE(bufoff, gbase, voff) do { _Pragma("unroll") for (int _i = 0; _i < 2; ++_i) \
        __builtin_amdgcn_global_load_lds((const unsigned*)((const char*)(gbase) + (voff)[_i]), (LAS unsigned*)(lds + (bufoff) + ldsw + _i * 8192), 16, 0, 0); } while (0)
#define PG8_LDA(dst, b, h) do { _Pragma("unroll") for (int m = 0; m < 4; ++m) _Pragma("unroll") for (int k = 0; k < 2; ++k) dst[m][k] = *(const LAS bf16x8*)(lds + PG8_SA(b, h) + aoff + m * 2048 + k * 1024); } while (0)
#define PG8_LDB(dst, b, h) do { _Pragma("unroll") for (int n = 0; n < 2; ++n) _Pragma("unroll") for (int k = 0; k < 2; ++k) dst[n][k] = *(const LAS bf16x8*)(lds + PG8_SB(b, h) + boff + n * 2048 + k * 1024); } while (0)
#define PG8_MMA(ai, bj, At, Bt) do { __builtin_amdgcn_s_setprio(1); _Pragma("unroll") for (int m = 0; m < 4; ++m) _Pragma("unroll") for (int n = 0; n < 2; ++n) _Pragma("unroll") for (int k = 0; k < 2; ++k) \
        acc[ai][bj][m][n] = __builtin_amdgcn_mfma_f32_16x16x32_bf16(Bt[n][k], At[m][k], acc[ai][bj][m][n], 0, 0, 0); __builtin_amdgcn_s_setprio(0); } while (0)
#define PG8_WAIT_V(n) asm volatile("s_waitcnt vmcnt(" #n ")" ::: "memory")
#define PG8_WAIT_L(n) asm volatile("s_waitcnt lgkmcnt(" #n ")" ::: "memory")
#define PG8_BAR __builtin_amdgcn_s_barrier()
#define PG8_SCHED __builtin_amdgcn_sched_barrier(0)
    Unit cur, nxt; int ui = 0;
    if (!S.next(0, cur)) return;
    S.ready(cur);
    f32x4 acc[2][2][4][2];
#pragma unroll
    for (int a = 0; a < 2; ++a)
#pragma unroll
        for (int b = 0; b < 2; ++b)
#pragma unroll
            for (int m = 0; m < 4; ++m)
#pragma unroll
                for (int n = 0; n < 2; ++n) acc[a][b][m][n] = (f32x4){0.f, 0.f, 0.f, 0.f};
    bf16x8 At[4][2], B0[2][2], B1[2][2];
    const char* cA = cur.A; const char* cB = cur.B;
    if constexpr (HALF_M) {
        PG8_STAGE(PG8_SB(0, 0), cB, voffB); PG8_STAGE(PG8_SB(0, 1), cB + hstepB, voffB); PG8_STAGE(PG8_SA(0, 0), cA, voffA);
        if (wr == 1) PG8_BAR;
        PG8_WAIT_V(0); PG8_BAR;
        PG8_STAGE(PG8_SB(1, 0), cB + kstep, voffB); PG8_STAGE(PG8_SA(1, 0), cA + kstep, voffA); PG8_STAGE(PG8_SB(1, 1), cB + hstepB + kstep, voffB);
        PG8_BAR;
    } else {
    PG8_STAGE(PG8_SB(0, 0), cB, voffB); PG8_STAGE(PG8_SB(0, 1), cB + hstepB, voffB); PG8_STAGE(PG8_SA(0, 0), cA, voffA); PG8_STAGE(PG8_SA(0, 1), cA + hstepA, voffA);
    if (wr == 1) PG8_BAR;
    PG8_WAIT_V(2); PG8_BAR;
    PG8_STAGE(PG8_SB(1, 0), cB + kstep, voffB); PG8_STAGE(PG8_SA(1, 0), cA + kstep, voffA); PG8_STAGE(PG8_SB(1, 1), cB + hstepB + kstep, voffB);
    PG8_WAIT_V(6); PG8_BAR;
    }
    for (;;) {
        const bool has_next = S.next(ui + 1, nxt);
        if (has_next) S.ready(nxt);
        const char* nA = has_next ? nxt.A : cA; const char* nB = has_next ? nxt.B : cB;
        const int nt = cur.nt;
        for (int t = 0; t < nt; t += 2) {
            const bool last = (t == nt - 2);
            const char* a1 = cA + (size_t)(t + 1) * kstep;
            const char* a2 = last ? nA : cA + (size_t)(t + 2) * kstep; const char* b2 = last ? nB : cB + (size_t)(t + 2) * kstep;
            const char* a3 = a2 + kstep; const char* b3 = b2 + kstep;
            if constexpr (HALF_M) {
            (void)a1;
            PG8_LDB(B0, 0, 0); PG8_LDB(B1, 0, 1); PG8_SCHED; PG8_LDA(At, 0, 0);
            PG8_WAIT_L(0); PG8_BAR; PG8_MMA(0, 0, At, B0); PG8_MMA(0, 1, At, B1); PG8_BAR; PG8_SCHED;
            PG8_STAGE(PG8_SB(0, 0), b2, voffB); PG8_STAGE(PG8_SB(0, 1), b2 + hstepB, voffB); PG8_STAGE(PG8_SA(0, 0), a2, voffA);
            PG8_WAIT_V(6); PG8_BAR; PG8_BAR; PG8_SCHED;
            PG8_LDB(B0, 1, 0); PG8_LDB(B1, 1, 1); PG8_SCHED; PG8_LDA(At, 1, 0);
            PG8_WAIT_L(0); PG8_BAR; PG8_MMA(0, 0, At, B0); PG8_MMA(0, 1, At, B1); PG8_BAR; PG8_SCHED;
            PG8_STAGE(PG8_SB(1, 0), b3, voffB); PG8_STAGE(PG8_SB(1, 1), b3 + hstepB, voffB); PG8_STAGE(PG8_SA(1, 0), a3, voffA);
            PG8_WAIT_V(6); PG8_BAR; PG8_BAR; PG8_SCHED;
            } else {
            PG8_LDB(B0, 0, 0); PG8_LDB(B1, 0, 1); PG8_SCHED; PG8_LDA(At, 0, 0); PG8_STAGE(PG8_SA(1, 1), a1 + hstepA, voffA);
            PG8_WAIT_V(8); PG8_WAIT_L(0); PG8_BAR; PG8_MMA(0, 0, At, B0); PG8_MMA(0, 1, At, B1); PG8_BAR; PG8_SCHED;
            PG8_LDA(At, 0, 1); PG8_STAGE(PG8_SB(0, 0), b2, voffB); PG8_STAGE(PG8_SB(0, 1), b2 + hstepB, voffB); PG8_STAGE(PG8_SA(0, 0), a2, voffA);
            PG8_WAIT_V(8); PG8_WAIT_L(0); PG8_BAR; PG8_MMA(1, 0, At, B0); PG8_MMA(1, 1, At, B1); PG8_BAR; PG8_SCHED;
            PG8_LDB(B0, 1, 0); PG8_LDB(B1, 1, 1); PG8_SCHED; PG8_LDA(At, 1, 0); PG8_STAGE(PG8_SA(0, 1), a2 + hstepA, voffA);
            PG8_WAIT_V(8); PG8_WAIT_L(0); PG8_BAR; PG8_MMA(0, 0, At, B0); PG8_MMA(0, 1, At, B1); PG8_BAR; PG8_SCHED;
            PG8_LDA(At, 1, 1); PG8_STAGE(PG8_SB(1, 0), b3, voffB); PG8_STAGE(PG8_SB(1, 1), b3 + hstepB, voffB); PG8_STAGE(PG8_SA(1, 0), a3, voffA);
            PG8_WAIT_V(8); PG8_WAIT_L(0); PG8_BAR; PG8_MMA(1, 0, At, B0); PG8_MMA(1, 1, At, B1); PG8_BAR; PG8_SCHED;
            }
        }
        if (wr == 0) PG8_BAR;
        if constexpr (!Epi::AFTER_DRAIN) E(acc, cur, wr, wc, fr, fq);
        if (!has_next) break;
        if (!Epi::keep_acc(cur)) {
#pragma unroll
        for (int a = 0; a < 2; ++a)
#pragma unroll
            for (int b = 0; b < 2; ++b)
#pragma unroll
                for (int m = 0; m < 4; ++m)
#pragma unroll
                    for (int n = 0; n < 2; ++n) acc[a][b][m][n] = (f32x4){0.f, 0.f, 0.f, 0.f};
        }
        cur = nxt; cA = nA; cB = nB; ++ui;
        if (wr == 1) PG8_BAR;
    }
    PG8_WAIT_V(0);
    PG8_BAR;
    if constexpr (Epi::AFTER_DRAIN) E.fused(acc, cur, wr, wc, fr, fq, lds, wid, lane);
#undef PG8_SA
#undef PG8_SB
#undef PG8_STAGE
#undef PG8_LDA
#undef PG8_LDB
#undef PG8_MMA
#undef PG8_WAIT_V
#undef PG8_WAIT_L
#undef PG8_BAR
#undef PG8_SCHED
}
}
using pg8::Unit;
typedef f32x4 Acc[2][2][4][2];

struct SchedP1 { const char* A; const char* B; int G, c; unsigned* cnt; volatile LAS unsigned* alldone; int nconv;
    __device__ __forceinline__ void ready(const Unit& u) const {
        if (cnt == nullptr || u.pn < 14) return;
        { const unsigned fs = *alldone; if (fs != 0u && (unsigned)u.seq >= fs) return; }
        if (threadIdx.x < 64) { unsigned sp = 0;
            while ((unsigned)__builtin_amdgcn_readfirstlane(__hip_atomic_load(cnt + 32 * u.pn, __ATOMIC_RELAXED, __HIP_MEMORY_SCOPE_AGENT)) < 128u) { __builtin_amdgcn_s_sleep(2); if (++sp > (1u << 22)) break; }
            const unsigned wd = (unsigned)__builtin_amdgcn_readfirstlane(__hip_atomic_load(cnt + 32 * 48, __ATOMIC_RELAXED, __HIP_MEMORY_SCOPE_AGENT));
            __builtin_amdgcn_fence(__ATOMIC_ACQUIRE, "agent"); asm volatile("s_waitcnt vmcnt(0)" ::: "memory");
            if (wd >= (unsigned)nconv && threadIdx.x == 0) *alldone = (unsigned)u.seq + 1u;
            asm volatile("s_waitcnt lgkmcnt(0)" ::: "memory"); }
        asm volatile("" ::: "memory"); __builtin_amdgcn_s_barrier(); asm volatile("" ::: "memory");
    }
    __device__ __forceinline__ bool next(int i, Unit& u) const {
        const int L = i * G + c; if (L >= 1536 + 24) return false;
        int pm, pn; if (L < 1536) pg8::tile_of(L, 32, 48, pm, pn); else { pm = 32; pn = L - 1536; }
        u.A = A + (size_t)pm * 256 * D * 2; u.B = B + (size_t)pn * 256 * D * 2; u.nt = D / 64; u.kind = 0; u.pm = pm; u.pn = pn; u.seq = i; return true; } };
struct SchedP3 { const char* A; const char* B; int G, c;
    __device__ __forceinline__ void ready(const Unit&) const {}
    __device__ __forceinline__ bool next(int i, Unit& u) const {
        const int L = (i >> 1) * G + c, part = i & 1; if (L >= 256) return false;
        int pm, pn; pg8::tile_of(L, 32, 8, pm, pn);
        u.A = A + ((size_t)pm * 256 * 4096 + (part ? 2048 : (pn >> 1) * 512)) * 2; u.B = B + ((size_t)pn * 256 * KCAT + (part ? 512 : 0)) * 2;
        u.nt = part ? 32 : 8; u.kind = part; u.pm = pm; u.pn = pn; return true; } };
struct SchedG { const char* A; const char* B; int G, c, nM, nN, K;
    __device__ __forceinline__ void ready(const Unit&) const {}
    __device__ __forceinline__ bool next(int i, Unit& u) const {
        const int L = i * G + c; if (L >= nM * nN) return false;
        int pm, pn; pg8::tile_of(L, nM, nN, pm, pn);
        u.A = A + (size_t)pm * 256 * K * 2; u.B = B + (size_t)pn * 256 * K * 2; u.nt = K / 64; u.kind = 0; u.pm = pm; u.pn = pn; return true; } };

struct SchedP5a { const char* A; const char* B; int G, c;
    __device__ __forceinline__ void ready(const Unit&) const {}
    __device__ __forceinline__ bool next(int i, Unit& u) const {
        const int L = i * G + c; if (L >= (G == 256 ? 1280 : 32 * 44)) return false;
        int pm, pn; pg8::tile_of(L, 32, 44, pm, pn);
        u.A = A + (size_t)pm * 256 * D * 2; u.B = B + (size_t)pn * 256 * D * 2; u.nt = D / 64; u.kind = 0; u.pm = pm; u.pn = pn; return true; } };
struct SchedP5b { const char* A; const char* B; int c;
    __device__ __forceinline__ void ready(const Unit&) const {}
    __device__ __forceinline__ bool next(int i, Unit& u) const {
        if (i > 0) return false;
        const int h = c >> 7; int pm, pn; pg8::tile_of(1280 + (c & 127), 32, 44, pm, pn);
        u.A = A + ((size_t)pm * 256 + h * 128) * D * 2; u.B = B + (size_t)pn * 256 * D * 2; u.nt = D / 64; u.kind = 4 | h; u.pm = pm; u.pn = pn; return true; } };

struct EpiP1 { static constexpr bool AFTER_DRAIN = false; static __device__ __forceinline__ bool keep_acc(const Unit&) { return false; } bf16_t* U; bf16_t* Sb; bf16_t* GB; bf16_t* GATES; const float* b_gate;
    __device__ __forceinline__ void operator()(const Acc& acc, const Unit& u, int wr, int wc, int fr, int fq) const {
        const int row0 = u.pm * 256 + wr * 64 + fr, cl = wc * 32 + 8 * fq, pn = u.pn;
        if (pn < 8 || (pn >= 24 && pn < 32)) {
            bf16_t* base = (pn < 8) ? U + pn * 256 : GB + (pn - 24) * 256;
#pragma unroll
            for (int ai = 0; ai < 2; ++ai)
#pragma unroll
                for (int m = 0; m < 4; ++m) { bf16_t* rowp = base + (size_t)(row0 + ai * 128 + m * 16) * D + cl;
#pragma unroll
                    for (int bj = 0; bj < 2; ++bj) NT_ST(pack8(acc[ai][bj][m][0], acc[ai][bj][m][1]), (u32x4*)(rowp + bj * 128)); }
        } else if (pn < 24) {
            bf16_t* base = Sb + (pn - 8) * 128 + cl;
#pragma unroll
            for (int ai = 0; ai < 2; ++ai)
#pragma unroll
                for (int m = 0; m < 4; ++m)
                    NT_ST(pack8(acc[ai][0][m][0] * acc[ai][1][m][0], acc[ai][0][m][1] * acc[ai][1][m][1]), (u32x4*)(base + (size_t)(row0 + ai * 128 + m * 16) * D));
        } else {
            const int col0 = (pn - 32) * 256 + cl;
            f32x4 bv[2][2];
#pragma unroll
            for (int bj = 0; bj < 2; ++bj)
#pragma unroll
                for (int n = 0; n < 2; ++n) bv[bj][n] = *(const f32x4*)(b_gate + col0 + bj * 128 + 4 * n);
#pragma unroll
            for (int ai = 0; ai < 2; ++ai)
#pragma unroll
                for (int m = 0; m < 4; ++m) { bf16_t* rowp = GATES + (size_t)(row0 + ai * 128 + m * 16) * 4096 + col0;
#pragma unroll
                    for (int bj = 0; bj < 2; ++bj) { f32x4 v0 = acc[ai][bj][m][0] + bv[bj][0], v1 = acc[ai][bj][m][1] + bv[bj][1];
#pragma unroll
                        for (int j = 0; j < 4; ++j) { v0[j] = sigmoidf_fast(v0[j]); v1[j] = sigmoidf_fast(v1[j]); }
                        NT_ST(pack8(v0, v1), (u32x4*)(rowp + bj * 128)); } }
        }
    }
};
struct EpiP3 { static constexpr bool AFTER_DRAIN = false; static __device__ __forceinline__ bool keep_acc(const Unit& u) { return u.kind == 0; }
    const bf16_t* GATES; bf16_t* Z;
    __device__ __forceinline__ void operator()(Acc& acc, const Unit& u, int wr, int wc, int fr, int fq) const {
        const int row0 = u.pm * 256 + wr * 64 + fr, col0 = u.pn * 256 + wc * 32 + 8 * fq;
        const bool k0 = (u.kind == 0);
        u32x4 gbuf[2][4];
#define P3_LOAD(buf, g) do { const size_t row_ = (size_t)(row0 + ((g) >> 2) * 128 + ((g) & 3) * 16); const bf16_t* gp_ = GATES + row_ * 4096 + col0; \
            gbuf[buf][0] = NT_LD((const u32x4*)(gp_ + 2048)); gbuf[buf][1] = NT_LD((const u32x4*)(gp_ + 2048 + 128)); \
            if (k0) { gbuf[buf][2] = NT_LD((const u32x4*)(gp_)); gbuf[buf][3] = NT_LD((const u32x4*)(gp_ + 128)); } } while (0)
        P3_LOAD(0, 0);
#pragma unroll
        for (int g = 0; g < 8; ++g) { const int ai = g >> 2, m = g & 3; const size_t row = (size_t)(row0 + ai * 128 + m * 16);
            if (g + 1 < 8) P3_LOAD((g + 1) & 1, g + 1);
#pragma unroll
            for (int bj = 0; bj < 2; ++bj) { const int col = col0 + bj * 128;
                float gb[8]; unpack8(gbuf[g & 1][bj], gb);
#pragma unroll
                for (int j = 0; j < 8; ++j) gb[j] = fmaxf(gb[j], 1e-30f);
                if (k0) {
                    float ga[8]; unpack8(gbuf[g & 1][2 + bj], ga);
#pragma unroll
                    for (int j = 0; j < 4; ++j) { acc[ai][bj][m][0][j] *= ga[j] * __builtin_amdgcn_rcpf(gb[j]); acc[ai][bj][m][1][j] *= ga[4 + j] * __builtin_amdgcn_rcpf(gb[4 + j]); }
                } else {
                    f32x4 v0 = acc[ai][bj][m][0], v1 = acc[ai][bj][m][1];
#pragma unroll
                    for (int j = 0; j < 4; ++j) { v0[j] *= gb[j]; v1[j] *= gb[4 + j]; }
                    *(u32x4*)(Z + row * D + col) = pack8(v0, v1); } }
            asm volatile("" ::: "memory"); }
#undef P3_LOAD
    }
};
struct EpiP4 { static constexpr bool AFTER_DRAIN = false; static __device__ __forceinline__ bool keep_acc(const Unit&) { return false; } const float* base; bf16_t* hb; float* ssq;
    __device__ __forceinline__ void operator()(const Acc& acc, const Unit& u, int wr, int wc, int fr, int fq) const {
        const int row0 = u.pm * 256 + wr * 64 + fr, col0 = u.pn * 256 + wc * 32 + 8 * fq;
        f32x4 xbuf[2][4];
#define P4_LOAD(buf, g) do { const float* xp_ = base + (size_t)(row0 + ((g) >> 2) * 128 + ((g) & 3) * 16) * D + col0; \
            xbuf[buf][0] = NT_LD((const f32x4*)(xp_)); xbuf[buf][1] = NT_LD((const f32x4*)(xp_ + 4)); xbuf[buf][2] = NT_LD((const f32x4*)(xp_ + 128)); xbuf[buf][3] = NT_LD((const f32x4*)(xp_ + 132)); } while (0)
        P4_LOAD(0, 0);
#pragma unroll
        for (int g = 0; g < 8; ++g) { const int ai = g >> 2, m = g & 3; const size_t row = (size_t)(row0 + ai * 128 + m * 16); float s = 0.f;
            if (g + 1 < 8) P4_LOAD((g + 1) & 1, g + 1);
#pragma unroll
            for (int bj = 0; bj < 2; ++bj) { const size_t off = row * D + col0 + bj * 128;
                const f32x4 v0 = xbuf[g & 1][2 * bj] + acc[ai][bj][m][0], v1 = xbuf[g & 1][2 * bj + 1] + acc[ai][bj][m][1];
                *(u32x4*)(hb + off) = pack8(v0, v1);
                s += (v0[0] * v0[0] + v0[1] * v0[1]) + (v0[2] * v0[2] + v0[3] * v0[3]) + (v1[0] * v1[0] + v1[1] * v1[1]) + (v1[2] * v1[2] + v1[3] * v1[3]); }
            s += __shfl_xor(s, 16); s += __shfl_xor(s, 32);
            if (fq == 0) ssq[row * 32 + u.pn * 4 + wc] = s;
            asm volatile("" ::: "memory"); }
#undef P4_LOAD
    }
};
struct EpiP6F { static constexpr bool AFTER_DRAIN = true; static __device__ __forceinline__ bool keep_acc(const Unit&) { return false; } const bf16_t* h1b; float* out; const float* gfin; unsigned* xbuf; unsigned* cnt;
    __device__ __forceinline__ void operator()(const Acc&, const Unit&, int, int, int, int) const {}
    __device__ __forceinline__ void fused(Acc& acc, const Unit& u, int wr, int wc, int fr, int fq, LAS unsigned char* lds, int wid, int lane) const {
        LAS float* P = (LAS float*)lds;
        LAS float* S = (LAS float*)(lds + 4096);
        const int row0 = u.pm * 256 + wr * 64 + fr, col0 = u.pn * 256 + wc * 32 + 8 * fq;
#pragma unroll
        for (int ai = 0; ai < 2; ++ai)
#pragma unroll
            for (int m = 0; m < 4; ++m) { const size_t row = (size_t)(row0 + ai * 128 + m * 16); float s = 0.f;
#pragma unroll
                for (int bj = 0; bj < 2; ++bj) { float h[8]; unpack8(NT_LD((const u32x4*)(h1b + row * D + col0 + bj * 128)), h);
#pragma unroll
                    for (int j = 0; j < 4; ++j) { acc[ai][bj][m][0][j] += h[j]; acc[ai][bj][m][1][j] += h[4 + j]; }
                    const f32x4 v0 = acc[ai][bj][m][0], v1 = acc[ai][bj][m][1];
                    s += (v0[0] * v0[0] + v0[1] * v0[1]) + (v0[2] * v0[2] + v0[3] * v0[3]) + (v1[0] * v1[0] + v1[1] * v1[1]) + (v1[2] * v1[2] + v1[3] * v1[3]); }
                s += __shfl_xor(s, 16); s += __shfl_xor(s, 32);
                if (fq == 0) P[(ai * 128 + wr * 64 + m * 16 + fr) * 4 + wc] = s; }
        asm volatile("s_waitcnt lgkmcnt(0)" ::: "memory"); __builtin_amdgcn_s_barrier(); asm volatile("" ::: "memory");
        const int rl = wid * 32 + (lane & 31);
        if (lane < 32) { const float t = (P[rl * 4 + 0] + P[rl * 4 + 1]) + (P[rl * 4 + 2] + P[rl * 4 + 3]);
            __hip_atomic_store(xbuf + ((size_t)(u.pm * 256 + rl) * 8 + u.pn), __float_as_uint(t), __ATOMIC_RELAXED, __HIP_MEMORY_SCOPE_AGENT); }
        asm volatile("s_waitcnt vmcnt(0)" ::: "memory");
        if (lane == 0) __hip_atomic_fetch_add(cnt + 64 * u.pm, 1u, __ATOMIC_RELAXED, __HIP_MEMORY_SCOPE_AGENT);
        if (wid == 0) { unsigned sp = 0;
            while ((unsigned)__builtin_amdgcn_readfirstlane(__hip_atomic_load(cnt + 64 * u.pm, __ATOMIC_RELAXED, __HIP_MEMORY_SCOPE_AGENT)) < 64u) { __builtin_amdgcn_s_sleep(2); if (++sp > (1u << 22)) break; }
            __builtin_amdgcn_fence(__ATOMIC_ACQUIRE, "agent"); }
        asm volatile("s_waitcnt vmcnt(0) lgkmcnt(0)" ::: "memory"); __builtin_amdgcn_s_barrier(); asm volatile("" ::: "memory");
        if (lane < 32) { const unsigned* slot = xbuf + (size_t)(u.pm * 256 + rl) * 8; float t = 0.f;
#pragma unroll
            for (int k = 0; k < 8; ++k) t += __uint_as_float(__hip_atomic_load(slot + k, __ATOMIC_RELAXED, __HIP_MEMORY_SCOPE_AGENT));
            S[rl] = 1.0f / sqrtf(t * (1.0f / D) + EPS); }
        asm volatile("s_waitcnt lgkmcnt(0)" ::: "memory"); __builtin_amdgcn_s_barrier(); asm volatile("" ::: "memory");
        f32x4 gv[2][2];
#pragma unroll
        for (int bj = 0; bj < 2; ++bj)
#pragma unroll
            for (int n = 0; n < 2; ++n) gv[bj][n] = *(const f32x4*)(gfin + col0 + bj * 128 + 4 * n);
#pragma unroll
        for (int ai = 0; ai < 2; ++ai)
#pragma unroll
            for (int m = 0; m < 4; ++m) { const int rloc = ai * 128 + wr * 64 + m * 16 + fr; const float rstd = S[rloc]; float* rowp = out + (size_t)(u.pm * 256 + rloc) * D + col0;
#pragma unroll
                for (int bj = 0; bj < 2; ++bj) { NT_ST(acc[ai][bj][m][0] * rstd * gv[bj][0], (f32x4*)(rowp + bj * 128)); NT_ST(acc[ai][bj][m][1] * rstd * gv[bj][1], (f32x4*)(rowp + bj * 128 + 4)); } }
    }
};
struct EpiP5 { static constexpr bool AFTER_DRAIN = false; static __device__ __forceinline__ bool keep_acc(const Unit&) { return false; } const float* ssq; bf16_t* ACT;
    __device__ __forceinline__ void operator()(const Acc& acc, const Unit& u, int wr, int wc, int fr, int fq) const {
        const bool half = (u.kind & 4) != 0;
        const int row0 = u.pm * 256 + (half ? (u.kind & 1) * 128 : 0) + wr * 64 + fr, col0 = u.pn * 128 + wc * 32 + 8 * fq;
#pragma unroll
        for (int ai = 0; ai < 2; ++ai) { if (ai == 1 && half) break;
#pragma unroll
            for (int m = 0; m < 4; ++m) { const size_t row = (size_t)(row0 + ai * 128 + m * 16);
                const f32x4 p0 = *(const f32x4*)(ssq + row * 32 + 8 * fq), p1 = *(const f32x4*)(ssq + row * 32 + 8 * fq + 4);
                float s = ((p0[0] + p0[1]) + (p0[2] + p0[3])) + ((p1[0] + p1[1]) + (p1[2] + p1[3]));
                s += __shfl_xor(s, 16); s += __shfl_xor(s, 32);
                const float rstd = __builtin_amdgcn_rsqf(s * (1.0f / D) + EPS);
                f32x4 o[2];
#pragma unroll
                for (int n = 0; n < 2; ++n)
#pragma unroll
                    for (int j = 0; j < 4; ++j) { const float g = acc[ai][0][m][n][j] * rstd, up = acc[ai][1][m][n][j] * rstd; o[n][j] = g * sigmoidf_fast(g) * up; }
                NT_ST(pack8(o[0], o[1]), (u32x4*)(ACT + row * FF + col0)); } }
    }
};

__device__ __forceinline__ void tr_item(const float* __restrict__ W, int N, int k0, int n0, bf16_t* WT, int ldT, int drow0, int kd0, const float* rs, const float* cs, LAS float* scr, int lane, bool wt = false) {
    const int r = lane >> 4, q = lane & 15;
    f32x4 v[16];
#pragma unroll
    for (int j = 0; j < 16; ++j) v[j] = __builtin_nontemporal_load((const f32x4*)(W + (size_t)(k0 + 4 * j + r) * N + n0 + 4 * q));
#pragma unroll
    for (int j = 0; j < 16; ++j) { LAS float* d = scr + (4 * j + r) * 65 + 4 * q; d[0] = v[j][0]; d[1] = v[j][1]; d[2] = v[j][2]; d[3] = v[j][3]; }
    asm volatile("s_waitcnt lgkmcnt(0)" ::: "memory");
    const int c = lane & 7;
    f32x4 r0 = {1.f, 1.f, 1.f, 1.f}, r1 = {1.f, 1.f, 1.f, 1.f};
    if (rs) { r0 = *(const f32x4*)(rs + k0 + 8 * c); r1 = *(const f32x4*)(rs + k0 + 8 * c + 4); }
#pragma unroll
    for (int j = 0; j < 8; ++j) { const int n = (lane >> 3) + 8 * j; const LAS float* sp = scr + (8 * c) * 65 + n; const float sc = cs ? cs[n0 + n] : 1.0f;
        u32x4 o; o.x = cvt_pk_bf16(sp[0 * 65] * r0[0] * sc, sp[1 * 65] * r0[1] * sc); o.y = cvt_pk_bf16(sp[2 * 65] * r0[2] * sc, sp[3 * 65] * r0[3] * sc);
        o.z = cvt_pk_bf16(sp[4 * 65] * r1[0] * sc, sp[5 * 65] * r1[1] * sc); o.w = cvt_pk_bf16(sp[6 * 65] * r1[2] * sc, sp[7 * 65] * r1[3] * sc);
        if (wt) st16_wt(WT + (size_t)(drow0 + n) * ldT + kd0 + k0 + 8 * c, o); else *(u32x4*)(WT + (size_t)(drow0 + n) * ldT + kd0 + k0 + 8 * c) = o; }
    asm volatile("s_waitcnt lgkmcnt(0)" ::: "memory");
}
__device__ __forceinline__ void rms_row_to_bf16(const float* src, const float* g, bf16_t* dst, int lane) {
    u32x4* o = (u32x4*)dst;
    if (!src) {
#pragma unroll
        for (int j = 0; j < 4; ++j) o[lane + 64 * j] = (u32x4){0u, 0u, 0u, 0u};
        return; }
    const f32x4* xr = (const f32x4*)src; const f32x4* gr = (const f32x4*)g;
    f32x4 v[4][2]; float s = 0.f;
#pragma unroll
    for (int j = 0; j < 4; ++j)
#pragma unroll
        for (int h = 0; h < 2; ++h) { v[j][h] = NT_LD(xr + 2 * (lane + 64 * j) + h); s += (v[j][h][0] * v[j][h][0] + v[j][h][1] * v[j][h][1]) + (v[j][h][2] * v[j][h][2] + v[j][h][3] * v[j][h][3]); }
    const float rstd = 1.0f / sqrtf(wave_sum(s) * (1.0f / D) + EPS);
#pragma unroll
    for (int j = 0; j < 4; ++j) { const f32x4 g0 = gr[2 * (lane + 64 * j)], g1 = gr[2 * (lane + 64 * j) + 1];
        o[lane + 64 * j] = pack8(v[j][0] * rstd * g0, v[j][1] * rstd * g1); }
}


__device__ __forceinline__ int seq_row(int b, int l) { return l >= NMETA ? b * SEQ + (l - NMETA) : MX + l; }
template <int W> __device__ __forceinline__ void pool_task(const bf16_t* U, bf16_t* ACT2, int b, int t0, int col) {
    constexpr int NR = W + 7;
    u32x4 raw[NR];
#pragma unroll
    for (int k = 0; k < NR; ++k) raw[k] = *(const u32x4*)(U + (size_t)seq_row(b, t0 + NMETA - (W - 1) + k) * D + col);
    float sum[8];
#pragma unroll
    for (int j = 0; j < 8; ++j) sum[j] = 0.f;
#pragma unroll
    for (int k = 0; k < W - 1; ++k) { float f[8]; unpack8(raw[k], f);
#pragma unroll
        for (int j = 0; j < 8; ++j) sum[j] += f[j]; }
    const float inv = 1.0f / (float)W;
#pragma unroll
    for (int r = 0; r < 8; ++r) { float fn[8], fo[8]; unpack8(raw[W - 1 + r], fn); unpack8(raw[r], fo);
        f32x4 o0, o1;
#pragma unroll
        for (int j = 0; j < 8; ++j) sum[j] += fn[j];
#pragma unroll
        for (int j = 0; j < 4; ++j) { o0[j] = sum[j] * inv - fn[j]; o1[j] = sum[4 + j] * inv - fn[4 + j]; }
#pragma unroll
        for (int j = 0; j < 8; ++j) sum[j] -= fo[j];
        *(u32x4*)(ACT2 + (size_t)(b * SEQ + t0 + r) * 4096 + col) = pack8(o0, o1); }
}
__device__ __forceinline__ void conv_task(const bf16_t* Sb, const bf16_t* GB, const float* conv_w, bf16_t* ACT2, int b, int t0, int col) {
    u32x4 sr[10], gr[8];
#pragma unroll
    for (int k = 0; k < 10; ++k) sr[k] = *(const u32x4*)(Sb + (size_t)seq_row(b, t0 + NMETA - 2 + k) * D + col);
#pragma unroll
    for (int r = 0; r < 8; ++r) gr[r] = *(const u32x4*)(GB + (size_t)(b * SEQ + t0 + r) * D + col);
    float w0[8], w1[8], w2[8];
#pragma unroll
    for (int h = 0; h < 2; ++h) { const f32x4 a = *(const f32x4*)(conv_w + col + 4 * h), bb = *(const f32x4*)(conv_w + D + col + 4 * h), c = *(const f32x4*)(conv_w + 2 * D + col + 4 * h);
#pragma unroll
        for (int j = 0; j < 4; ++j) { w0[4 * h + j] = a[j]; w1[4 * h + j] = bb[j]; w2[4 * h + j] = c[j]; } }
#pragma unroll
    for (int r = 0; r < 8; ++r) { float s0[8], s1[8], s2[8], g[8]; unpack8(sr[r], s0); unpack8(sr[r + 1], s1); unpack8(sr[r + 2], s2); unpack8(gr[r], g);
        f32x4 o0, o1;
#pragma unroll
        for (int j = 0; j < 4; ++j) { o0[j] = g[j] * (w0[j] * s0[j] + w1[j] * s1[j] + w2[j] * s2[j]); o1[j] = g[4 + j] * (w0[4 + j] * s0[4 + j] + w1[4 + j] * s1[4 + j] + w2[4 + j] * s2[4 + j]); }
        *(u32x4*)(ACT2 + (size_t)(b * SEQ + t0 + r) * 4096 + 2048 + col) = pack8(o0, o1); }
}

#define XB_TMO      128
#define XB_XCNT(j)  (256  + 64 * (j))
#define XB_XSUB(j)  (1280 + 64 * (j))
#define XB_XGEN(j)  (2304 + 64 * (j))
#define XB_TOP      3328
#define XB_TOPGEN   3392
#define XCD_BAR_WORDS 3456
#define XB_SPIN_CAP (1u << 18)
__device__ __forceinline__ unsigned xb_ld(unsigned* p)              { return __hip_atomic_load(p, __ATOMIC_RELAXED, __HIP_MEMORY_SCOPE_AGENT); }
__device__ __forceinline__ unsigned xb_add(unsigned* p, unsigned v) { return __hip_atomic_fetch_add(p, v, __ATOMIC_RELAXED, __HIP_MEMORY_SCOPE_AGENT); }
__device__ __forceinline__ unsigned xb_xcc_id() { return (unsigned)__builtin_amdgcn_s_getreg((3 << 11) | 20) & 0xFu; }
#define XB_SPIN(cond, bar) do { unsigned _sp = 0; while (cond) { __builtin_amdgcn_s_sleep(1); \
    if ((++_sp & 255u) == 0u) { if (xb_ld(&(bar)[XB_TMO])) break; if (_sp > XB_SPIN_CAP) { atomicAdd(&(bar)[XB_TMO], 1u); break; } } } } while (0)
struct XcdBarrier { unsigned* bar; unsigned x; volatile LAS unsigned* st; };
__device__ __forceinline__ XcdBarrier xcd_barrier_post(unsigned* bar, volatile LAS unsigned* st) {
    XcdBarrier b; b.bar = bar; b.x = xb_xcc_id(); b.st = st;
    if (threadIdx.x == 0) (void)xb_add(&bar[XB_XCNT(b.x)], 1u);
    return b;
}
__device__ __forceinline__ void xcd_barrier_complete(unsigned* bar, unsigned x, unsigned& nloc, unsigned& nx) {
    const unsigned G = gridDim.x * gridDim.y * gridDim.z;
    unsigned sum, cnt, mine, sp = 0u;
    for (;;) {
        sum = 0u; cnt = 0u; mine = 0u;
#pragma unroll
        for (unsigned j = 0; j < 16; ++j) { const unsigned c = xb_ld(&bar[XB_XCNT(j)]); sum += c; cnt += (c > 0u) ? 1u : 0u; mine = (j == x) ? c : mine; }
        if (sum == G) break;
        __builtin_amdgcn_s_sleep(1);
        if ((++sp & 255u) == 0u) { if (xb_ld(&bar[XB_TMO])) break; if (sp > XB_SPIN_CAP) { atomicAdd(&bar[XB_TMO], 1u); break; } }
    }
    nloc = mine > 0u ? mine : 1u; nx = cnt > 0u ? cnt : 1u;
}
__device__ __forceinline__ void xcd_barrier(const XcdBarrier& b) {
    asm volatile("s_waitcnt vmcnt(0)" ::: "memory");
    __syncthreads();
    if (threadIdx.x == 0) {
        unsigned* bar = b.bar;
        __builtin_amdgcn_s_waitcnt(0);
        unsigned nloc = b.st[0], nx = b.st[1];
        if (nloc == 0u) { xcd_barrier_complete(bar, b.x, nloc, nx); b.st[0] = nloc; b.st[1] = nx; }
        const unsigned old = xb_add(&bar[XB_XSUB(b.x)], 1u);
        const unsigned gen = old / nloc;
        if (old + 1u == (gen + 1u) * nloc) {
            __builtin_amdgcn_fence(__ATOMIC_RELEASE, "agent");
            asm volatile("s_waitcnt vmcnt(0)" ::: "memory");
            const unsigned og = xb_add(&bar[XB_TOP], 1u);
            const unsigned tg = og / nx;
            if (og + 1u == (tg + 1u) * nx) xb_add(&bar[XB_TOPGEN], 1u);
            else XB_SPIN(xb_ld(&bar[XB_TOPGEN]) == tg, bar);
            __builtin_amdgcn_fence(__ATOMIC_ACQUIRE, "agent");
            xb_add(&bar[XB_XGEN(b.x)], 1u);
            asm volatile("s_waitcnt vmcnt(0)" ::: "memory");
        } else {
            XB_SPIN(xb_ld(&bar[XB_XGEN(b.x)]) == gen, bar);
            __builtin_amdgcn_fence(__ATOMIC_ACQUIRE, "agent");
            asm volatile("s_waitcnt vmcnt(0)" ::: "memory");
        }
    }
    __syncthreads();
}

struct Args { const float* in[14]; float* out; unsigned char* ws; int ph_lo, ph_hi; };

__global__ void __launch_bounds__(512, 2) fwd_megakernel(Args a) {
    extern __shared__ __attribute__((aligned(16))) unsigned char lds_raw[];
    LAS unsigned char* lds = (LAS unsigned char*)lds_raw;
    cg::grid_group grid = cg::this_grid();
    const int tid = threadIdx.x, lane = tid & 63, wave = __builtin_amdgcn_readfirstlane(tid >> 6);
    const int G = gridDim.x, bx = blockIdx.x;
    const int vcu = (G % 8 == 0) ? (bx % 8) * (G / 8) + bx / 8 : bx;
    const int gw = vcu * 8 + wave, NGW = G * 8;
    unsigned char* ws = a.ws;
    const float* x = a.in[0]; const float* meta = a.in[1]; const float* g_mix = a.in[2]; const float* w_in = a.in[3]; const float* b_gate = a.in[4];
    const float* pool_w = a.in[5]; const float* pool_scale = a.in[6]; const float* conv_w = a.in[7]; const float* conv_out_w = a.in[8]; const float* w_o = a.in[9];
    const float* g_ffn = a.in[10]; const float* w_gu = a.in[11]; const float* w_down = a.in[12]; const float* g_final = a.in[13];
    float* out = a.out;
    bf16_t* WdT = (bf16_t*)(ws + WS_WD); bf16_t* WguT = (bf16_t*)(ws + WS_WGU); bf16_t* WoT = (bf16_t*)(ws + WS_WO); bf16_t* Bcat = (bf16_t*)(ws + WS_BCAT); bf16_t* WinT = (bf16_t*)(ws + WS_WIN);
    bf16_t* HN = (bf16_t*)(ws + WS_HN); bf16_t* U = (bf16_t*)(ws + WS_U); bf16_t* Sb = (bf16_t*)(ws + WS_S); bf16_t* GB = (bf16_t*)(ws + WS_GB); bf16_t* GATES = (bf16_t*)(ws + WS_GATES);
    bf16_t* ACT2 = (bf16_t*)(ws + WS_ACT2); float* ZA = (float*)(ws + WS_ZA); bf16_t* Z = (bf16_t*)(ws + WS_Z); bf16_t* H1B = (bf16_t*)(ws + WS_H1B); bf16_t* ACT = (bf16_t*)(ws + WS_ACT);
    float* SSQ1 = (float*)(ws + WS_SSQ1); float* SSQ2 = (float*)(ws + WS_SSQ2);

    const int lo = a.ph_lo, hi = a.ph_hi;
    if (lo < 0) grid.sync();
    XcdBarrier xbar; xbar.bar = (unsigned*)ws; xbar.x = 0; xbar.st = nullptr;
#if MK_N_LAUNCHES == 1
    { volatile LAS unsigned* st = (volatile LAS unsigned*)(lds + LDS_BYTES - 64); if (tid < 16) st[tid] = 0u; __syncthreads(); xbar = xcd_barrier_post((unsigned*)ws, st); }
#endif
#define IN(k) (lo <= (k) && (k) < hi)
#if MK_N_LAUNCHES == 1
#define GSYNC() xcd_barrier(xbar)
#else
#define GSYNC() do {} while (0)
#endif
#define SEAM(k) do { if (IN(k) && IN((k) + 1)) GSYNC(); } while (0)

    constexpr int I_WIN = 32 * 192, I_WGU = 32 * 176, I_WO = 32 * 32, I_CO = 32 * 32, I_PW = 4 * 8 * 8, I_WD = 88 * 32;
    constexpr int IT_MID = I_WIN + I_WGU + I_WO + I_CO + I_PW, NITEMS = IT_MID + I_WD;
    constexpr int G_GEMM = 224, P0_TILES = 14;
    const bool split_conv = (G == 256) && (MK_N_LAUNCHES == 1);
#define CONVERT_ITEMS(lo_, hi_, w_, nw_, cnt_) do { int lane = tid & 63, wv_ = wave; asm volatile("" : "+v"(lane), "+s"(wv_));   \
        LAS float* scr = (LAS float*)(lds + wv_ * 16640); unsigned* const cntp_ = (cnt_); \
        for (int it = (lo_) + (w_); it < (hi_); it += (nw_)) { int r = it; \
            if (r < I_WIN) {   \
                const int t_ = r >> 7, kb = (r & 127) >> 2, sub = r & 3; \
                const int nb = t_ < 8 ? 4 * t_ + sub : (t_ < 24 ? (sub < 2 ? 64 + 2 * (t_ - 8) + sub : 96 + 2 * (t_ - 8) + (sub - 2)) : (t_ < 32 ? 32 + 4 * (t_ - 24) + sub : 128 + 4 * (t_ - 32) + sub)); \
                const int n0 = 64 * nb; int drow; \
                if (n0 < 2048) drow = n0; \
                else if (n0 < 4096) drow = 6144 + (n0 - 2048); \
                else if (n0 < 6144) { const int cc = n0 - 4096; drow = 2048 + 256 * (cc >> 7) + (cc & 127); } \
                else if (n0 < 8192) { const int cc = n0 - 6144; drow = 2048 + 256 * (cc >> 7) + 128 + (cc & 127); } \
                else drow = n0; \
                tr_item(w_in, NIN, 64 * kb, n0, WinT, D, drow, 0, nullptr, nullptr, scr, lane, cntp_ != nullptr); \
                if (cntp_) { asm volatile("s_waitcnt vmcnt(0)" ::: "memory"); if (lane == 0) __hip_atomic_fetch_add(cntp_ + 32 * t_, 1u, __ATOMIC_RELAXED, __HIP_MEMORY_SCOPE_AGENT); } \
                continue; } r -= I_WIN; \
            if (r < I_WGU) { const int kb = r / 176, nb = r % 176, n0 = 64 * nb; int drow; \
                if (n0 < FF) drow = 256 * (n0 >> 7) + (n0 & 127); else { const int cc = n0 - FF; drow = 256 * (cc >> 7) + 128 + (cc & 127); } \
                tr_item(w_gu, NGU, 64 * kb, n0, WguT, D, drow, 0, g_ffn, nullptr, scr, lane); continue; } r -= I_WGU; \
            if (r < I_WO) { const int kb = r / 32, nb = r % 32; tr_item(w_o, D, 64 * kb, 64 * nb, WoT, D, 64 * nb, 0, nullptr, nullptr, scr, lane); continue; } r -= I_WO; \
            if (r < I_CO) { const int kb = r / 32, nb = r % 32; tr_item(conv_out_w, D, 64 * kb, 64 * nb, Bcat, KCAT, 64 * nb, 512, nullptr, nullptr, scr, lane); continue; } r -= I_CO; \
            if (r < I_PW) { const int g = r / 64, rr = r % 64, kb = rr / 8, nb = rr % 8; \
                tr_item(pool_w + (size_t)g * 512 * 512, 512, 64 * kb, 64 * nb, Bcat, KCAT, g * 512 + 64 * nb, 0, nullptr, pool_scale + g * 512, scr, lane); continue; } r -= I_PW; \
            { const int kb = r / 32, nb = r % 32; tr_item(w_down, D, 64 * kb, 64 * nb, WdT, FF, 64 * nb, 0, nullptr, nullptr, scr, lane); } \
        } } while (0)

    if (IN(0)) {
        CONVERT_ITEMS(0, split_conv ? P0_TILES * 128 : NITEMS, gw, NGW, nullptr);
        for (int m = gw; m < MA; m += NGW) {
            const float* src = m < MX ? x + (size_t)m * D : (m < MX + NMETA ? meta + (size_t)(m - MX) * D : nullptr);
            rms_row_to_bf16(src, g_mix, HN + (size_t)m * D, lane);
        }
    }
    SEAM(0);

    if (IN(1)) {
        unsigned* tcnt = (unsigned*)ws + 6144;
        if (!split_conv || bx < G_GEMM) {
            SchedP1 S{(const char*)HN, (const char*)WinT, split_conv ? G_GEMM : G, bx, split_conv ? tcnt : nullptr, (volatile LAS unsigned*)(lds + LDS_BYTES - 64) + 4, (G - G_GEMM) * 8};
            EpiP1 E{U, Sb, GB, GATES, b_gate};
            pg8::gemm_phase(lds, D, D, S, E);
        } else {
            const int cw = (bx - G_GEMM) * 8 + wave, ncw = (G - G_GEMM) * 8;
            CONVERT_ITEMS(P0_TILES * 128, I_WIN, cw, ncw, tcnt);
            if (lane == 0) __hip_atomic_fetch_add(tcnt + 32 * 48, 1u, __ATOMIC_RELAXED, __HIP_MEMORY_SCOPE_AGENT);
            CONVERT_ITEMS(I_WIN, NITEMS, cw, ncw, nullptr);
        }
    }
    SEAM(1);

    if (IN(2)) {
        const int nthr = G * 512;
        for (int idx = vcu * 512 + tid; idx < (MX / 8) * 256; idx += nthr) {
            const int cgp = idx & 255, rb = idx >> 8, b = rb >> 8, t0 = (rb & 255) * 8, col = cgp * 8;
            const int grp = col >> 9;
            if (grp == 0) pool_task<2>(U, ACT2, b, t0, col); else if (grp == 1) pool_task<4>(U, ACT2, b, t0, col); else if (grp == 2) pool_task<8>(U, ACT2, b, t0, col); else pool_task<16>(U, ACT2, b, t0, col);
            conv_task(Sb, GB, conv_w, ACT2, b, t0, col);
        }
    }
    SEAM(2);

    if (IN(3)) {
        SchedP3 S{(const char*)ACT2, (const char*)Bcat, G, bx};
        EpiP3 E{GATES, Z};
        pg8::gemm_phase(lds, 4096, KCAT, S, E);
    }
    SEAM(3);

    if (IN(4)) {
        SchedG S{(const char*)Z, (const char*)WoT, G, bx, 32, 8, D};
        EpiP4 E{x, H1B, SSQ1};
        pg8::gemm_phase(lds, D, D, S, E);
    }
    SEAM(4);

    if (IN(5)) {
        EpiP5 E{SSQ1, ACT};
        { SchedP5a S{(const char*)H1B, (const char*)WguT, G, bx}; pg8::gemm_phase(lds, D, D, S, E); }
        if (G == 256) { SchedP5b S2{(const char*)H1B, (const char*)WguT, bx}; pg8::gemm_phase<true>(lds, D, D, S2, E); }
        if (!split_conv && bx >= 128) CONVERT_ITEMS(IT_MID, NITEMS, (bx - 128) * 8 + wave, (G - 128) * 8, nullptr);
    }
    SEAM(5);

    if (IN(6)) {
        SchedG S{(const char*)ACT, (const char*)WdT, G, bx, 32, 8, FF};
        EpiP6F E{H1B, out, g_final, (unsigned*)(ws + WS_SSQ2), (unsigned*)ws + 4096};
        pg8::gemm_phase(lds, FF, FF, S, E);
    }
#undef IN
#undef SEAM
}

extern "C" void kernel_launch(void* const* d_in, const int* in_sizes, int n_in, void* d_out, int out_size, void* d_ws, size_t ws_size, hipStream_t stream) {
    static int grid = 0;
    if (grid == 0) {
        if (n_in != 14 || out_size != MX * D || ws_size < WS_END) { fprintf(stderr, "kernel_launch: unexpected shapes (n_in %d out %d ws %zu)\n", n_in, out_size, ws_size); grid = -1; return; }
        int dev = 0, cus = 0, per_cu = 0;
        if (hipGetDevice(&dev) != hipSuccess || hipDeviceGetAttribute(&cus, hipDeviceAttributeMultiprocessorCount, dev) != hipSuccess) { grid = -1; return; }
        if (hipFuncSetAttribute((const void*)fwd_megakernel, hipFuncAttributeMaxDynamicSharedMemorySize, LDS_BYTES) != hipSuccess) { fprintf(stderr, "kernel_launch: hipFuncSetAttribute failed\n"); grid = -1; return; }
        if (hipOccupancyMaxActiveBlocksPerMultiprocessor(&per_cu, (const void*)fwd_megakernel, 512, LDS_BYTES) != hipSuccess || per_cu < 1) { fprintf(stderr, "kernel_launch: occupancy query says %d blocks per CU\n", per_cu); per_cu = 1; }
        (void)hipGetLastError();
        if (cus != 256) { fprintf(stderr, "kernel_launch: built for a 256-CU device (got %d)\n", cus); grid = -1; return; }
        grid = cus;
    }
    if (grid < 0) return;
    if (hipMemsetAsync(d_ws, 0, 32768, stream) != hipSuccess) { fprintf(stderr, "kernel_launch: memset failed\n"); return; }
    Args a{};
    for (int i = 0; i < 14; ++i) a.in[i] = (const float*)d_in[i];
    a.out = (float*)d_out; a.ws = (unsigned char*)d_ws;
#if MK_N_LAUNCHES == 1
    a.ph_lo = 0; a.ph_hi = N_PHASES;
    void* args[] = {&a};
    hipError_t e = hipLaunchCooperativeKernel((const void*)fwd_megakernel, dim3(grid), dim3(512), args, LDS_BYTES, stream);
    if (e != hipSuccess) fprintf(stderr, "kernel_launch: cooperative launch failed: %s (grid %d)\n", hipGetErrorString(e), grid);
#else
    for (int p = 0; p < N_PHASES; ++p) { a.ph_lo = p; a.ph_hi = p + 1; hipLaunchKernelGGL(fwd_megakernel, dim3(grid), dim3(512), LDS_BYTES, stream, a); }
#endif
}
```

```cpp
#include <hip/hip_runtime.h>
#include <hip/hip_cooperative_groups.h>
#include <cstdio>
#include <cstdint>
namespace cg = cooperative_groups;

#define LAS __attribute__((address_space(3)))
typedef unsigned short bf16_t;
typedef short bf16x8 __attribute__((ext_vector_type(8)));
typedef float f32x4 __attribute__((ext_vector_type(4)));
typedef unsigned u32x4 __attribute__((ext_vector_type(4)));

#ifndef MK_N_LAUNCHES
#define MK_N_LAUNCHES 1
#endif
constexpr int N_PHASES = 7;

constexpr int D = 2048, SEQ = 2048, NBATCH = 4, NMETA = 16;
constexpr int MX = NBATCH * SEQ;
constexpr int MA = 33 * 256;
constexpr int NIN = 12288, FF = 5632, NGU = 2 * FF, KCAT = 512 + 2048;
constexpr float EPS = 1e-6f;

constexpr size_t MiB = 1u << 20;
constexpr size_t WS_SSQ1 = 1 * MiB, WS_SSQ2 = 2 * MiB;
constexpr size_t WS_WD = 4 * MiB;
constexpr size_t WS_WGU = 26 * MiB;
constexpr size_t WS_WO = 70 * MiB;
constexpr size_t WS_BCAT = 78 * MiB;
constexpr size_t WS_WIN = 88 * MiB;
constexpr size_t WS_HN = 136 * MiB;
constexpr size_t WS_U = 169 * MiB;
constexpr size_t WS_S = 202 * MiB;
constexpr size_t WS_GB = 235 * MiB;
constexpr size_t WS_GATES = 267 * MiB;
constexpr size_t WS_ACT2 = 88 * MiB;
constexpr size_t WS_ZA = 169 * MiB;
constexpr size_t WS_Z = 235 * MiB;
constexpr size_t WS_H1B = 169 * MiB;
constexpr size_t WS_ACT = 202 * MiB;
constexpr size_t WS_END = 331 * MiB;

constexpr int LDS_BYTES = 131072 + 4096;

#define NT_LD(p) __builtin_nontemporal_load(p)
#define NT_ST(v, p) (*(p) = (v))
__device__ __forceinline__ void st16_wt(void* p, const unsigned __attribute__((ext_vector_type(4))) v) { asm volatile("global_store_dwordx4 %0, %1, off sc1\n\ts_nop 1" :: "v"(p), "v"(v) : "memory"); }
typedef __bf16 bf16x2_t __attribute__((ext_vector_type(2)));
typedef float f32x2_t __attribute__((ext_vector_type(2)));
__device__ __forceinline__ unsigned cvt_pk_bf16(float lo, float hi) { const f32x2_t v = {lo, hi}; return __builtin_bit_cast(unsigned, __builtin_convertvector(v, bf16x2_t)); }
__device__ __forceinline__ float bf_lo(unsigned u) { return __uint_as_float(u << 16); }
__device__ __forceinline__ float bf_hi(unsigned u) { return __uint_as_float(u & 0xffff0000u); }
__device__ __forceinline__ void unpack8(const u32x4 w, float (&f)[8]) { f[0] = bf_lo(w.x); f[1] = bf_hi(w.x); f[2] = bf_lo(w.y); f[3] = bf_hi(w.y); f[4] = bf_lo(w.z); f[5] = bf_hi(w.z); f[6] = bf_lo(w.w); f[7] = bf_hi(w.w); }
__device__ __forceinline__ u32x4 pack8(const f32x4 a, const f32x4 b) { u32x4 w; w.x = cvt_pk_bf16(a[0], a[1]); w.y = cvt_pk_bf16(a[2], a[3]); w.z = cvt_pk_bf16(b[0], b[1]); w.w = cvt_pk_bf16(b[2], b[3]); return w; }
__device__ __forceinline__ float sigmoidf_fast(float x) { return __builtin_amdgcn_rcpf(1.0f + __builtin_amdgcn_exp2f(-1.44269504089f * x)); }
__device__ __forceinline__ float wave_sum(float v) {
#pragma unroll
    for (int o = 1; o < 64; o <<= 1) v += __shfl_xor(v, o);
    return v;
}

namespace pg8 {
constexpr int BM = 256, BK = 64, HALF = 128, HTB = HALF * BK * 2, STAGE_BYTES = 8 * HTB;
__device__ __forceinline__ int lds_byte(int r, int c) { const int st = (r >> 4) * 2 + (c >> 5), rr = r & 15, cc = c & 31, ob = rr * 64 + cc * 2; return st * 1024 + (ob ^ (((ob >> 9) & 1) << 5)); }
__device__ __forceinline__ void stage_rc(int b, int& R, int& C) { const int st = b / 1024, sb = b % 1024, swz = sb ^ (((sb >> 9) & 1) << 5); R = (st >> 1) * 16 + swz / 64; C = (st & 1) * 32 + (swz % 64) / 2; }
__device__ __forceinline__ int perm32(int rho) { const int n = rho >> 4, i = rho & 15; return 8 * (i >> 2) + 4 * n + (i & 3); }

struct Unit { const char* A; const char* B; int nt, kind, pm, pn; };

__device__ __forceinline__ void tile_of(int L, int nM, int nN, int& pm, int& pn) {
    const int nwg = nM * nN; int wgid = L;
    { const int q = nwg / 8, r = nwg % 8, xcd = wgid % 8, off = wgid / 8; wgid = (xcd < r ? xcd * (q + 1) : r * (q + 1) + (xcd - r) * q) + off; }
    constexpr int WGM = 4;
    const int nig = WGM * nN, gid = wgid / nig, fm = gid * WGM, gsz = (nM - fm) < WGM ? (nM - fm) : WGM;
    pm = fm + ((wgid % nig) % gsz); pn = (wgid % nig) / gsz;
}

template <bool HALF_M = false, class Sched, class Epi>
__device__ __forceinline__ void gemm_phase(LAS unsigned char* lds, const int ldA, const int ldB, const Sched& S, const Epi& E) {
    const int tid = threadIdx.x, wid = __builtin_amdgcn_readfirstlane(tid >> 6), lane = tid & 63, wr = wid >> 2, wc = wid & 3, fr = lane & 15, fq = lane >> 4;
    unsigned voffA[2], voffB[2];
#pragma unroll
    for (int i = 0; i < 2; ++i) { int R, C; stage_rc(tid * 16 + i * 8192, R, C); const int Rb = (R & ~31) + perm32(R & 31);
        voffA[i] = (unsigned)(R * ldA + C) * 2u; voffB[i] = (unsigned)(Rb * ldB + C) * 2u; }
    const size_t kstep = (size_t)(BK * 2);
    const size_t hstepA = (size_t)HALF * ldA * 2, hstepB = (size_t)HALF * ldB * 2;
    const unsigned ldsw = (unsigned)wid * 1024u;
    const int aoff = lds_byte(wr * 64 + fr, fq * 8), boff = lds_byte(wc * 32 + fr, fq * 8);
#define PG8_SA(b, h) (((b) * 2 + (h)) * HTB)
#define PG8_SB(b, h) ((4 + (b) * 2 + (h)) * HTB)
#define PG8_STAGE(bufoff, gbase, voff) do { _Pragma("unroll") for (int _i = 0; _i < 2; ++_i) \
        __builtin_amdgcn_global_load_lds((const unsigned*)((const char*)(gbase) + (voff)[_i]), (LAS unsigned*)(lds + (bufoff) + ldsw + _i * 8192), 16, 0, 0); } while (0)
#define PG8_LDA(dst, b, h) do { _Pragma("unroll") for (int m = 0; m < 4; ++m) _Pragma("unroll") for (int k = 0; k < 2; ++k) dst[m][k] = *(const LAS bf16x8*)(lds + PG8_SA(b, h) + aoff + m * 2048 + k * 1024); } while (0)
#define PG8_LDB(dst, b, h) do { _Pragma("unroll") for (int n = 0; n < 2; ++n) _Pragma("unroll") for (int k = 0; k < 2; ++k) dst[n][k] = *(const LAS bf16x8*)(lds + PG8_SB(b, h) + boff + n * 2048 + k * 1024); } while (0)
#define PG8_MMA(ai, bj, At, Bt) do { __builtin_amdgcn_s_setprio(1); _Pragma("unroll") for (int m = 0; m < 4; ++m) _Pragma("unroll") for (int n = 0; n < 2; ++n) _Pragma("unroll") for (int k = 0; k < 2; ++k) \
        acc[ai][bj][m][n] = __builtin_amdgcn_mfma_f32_16x16x32_bf16(Bt[n][k], At[m][k], acc[ai][bj][m][n], 0, 0, 0); __builtin_amdgcn_s_setprio(0); } while (0)
#define PG8_WAIT_V(n) asm volatile("s_waitcnt vmcnt(" #n ")" ::: "memory")
#define PG8_WAIT_L(n) asm volatile("s_waitcnt lgkmcnt(" #n ")" ::: "memory")
#define PG8_BAR __builtin_amdgcn_s_barrier()
#define PG8_SCHED __builtin_amdgcn_sched_barrier(0)
    Unit cur, nxt; int ui = 0;
    if (!S.next(0, cur)) return;
    S.ready(cur);
    f32x4 acc[2][2][4][2];
#pragma unroll
    for (int a = 0; a < 2; ++a)
#pragma unroll
        for (int b = 0; b < 2; ++b)
#pragma unroll
            for (int m = 0; m < 4; ++m)
#pragma unroll
                for (int n = 0; n < 2; ++n) acc[a][b][m][n] = (f32x4){0.f, 0.f, 0.f, 0.f};
    bf16x8 At[4][2], B0[2][2], B1[2][2];
    const char* cA = cur.A; const char* cB = cur.B;
    if constexpr (HALF_M) {
        PG8_STAGE(PG8_SB(0, 0), cB, voffB); PG8_STAGE(PG8_SB(0, 1), cB + hstepB, voffB); PG8_STAGE(PG8_SA(0, 0), cA, voffA);
        if (wr == 1) PG8_BAR;
        PG8_WAIT_V(0); PG8_BAR;
        PG8_STAGE(PG8_SB(1, 0), cB + kstep, voffB); PG8_STAGE(PG8_SA(1, 0), cA + kstep, voffA); PG8_STAGE(PG8_SB(1, 1), cB + hstepB + kstep, voffB);
        PG8_BAR;
    } else {
    PG8_STAGE(PG8_SB(0, 0), cB, voffB); PG8_STAGE(PG8_SB(0, 1), cB + hstepB, voffB); PG8_STAGE(PG8_SA(0, 0), cA, voffA); PG8_STAGE(PG8_SA(0, 1), cA + hstepA, voffA);
    if (wr == 1) PG8_BAR;
    PG8_WAIT_V(2); PG8_BAR;
    PG8_STAGE(PG8_SB(1, 0), cB + kstep, voffB); PG8_STAGE(PG8_SA(1, 0), cA + kstep, voffA); PG8_STAGE(PG8_SB(1, 1), cB + hstepB + kstep, voffB);
    PG8_WAIT_V(6); PG8_BAR;
    }
    for (;;) {
        const bool has_next = S.next(ui + 1, nxt);
        if (has_next) S.ready(nxt);
        const char* nA = has_next ? nxt.A : cA; const char* nB = has_next ? nxt.B : cB;
        const int nt = cur.nt;
        for (int t = 0; t < nt; t += 2) {
            const bool last = (t == nt - 2);
            const char* a1 = cA + (size_t)(t + 1) * kstep;
            const char* a2 = last ? nA : cA + (size_t)(t + 2) * kstep; const char* b2 = last ? nB : cB + (size_t)(t + 2) * kstep;
            const char* a3 = a2 + kstep; const char* b3 = b2 + kstep;
            if constexpr (HALF_M) {
            (void)a1;
            PG8_LDB(B0, 0, 0); PG8_LDB(B1, 0, 1); PG8_SCHED; PG8_LDA(At, 0, 0);
            PG8_WAIT_L(0); PG8_BAR; PG8_MMA(0, 0, At, B0); PG8_MMA(0, 1, At, B1); PG8_BAR; PG8_SCHED;
            PG8_STAGE(PG8_SB(0, 0), b2, voffB); PG8_STAGE(PG8_SB(0, 1), b2 + hstepB, voffB); PG8_STAGE(PG8_SA(0, 0), a2, voffA);
            PG8_WAIT_V(6); PG8_BAR; PG8_BAR; PG8_SCHED;
            PG8_LDB(B0, 1, 0); PG8_LDB(B1, 1, 1); PG8_SCHED; PG8_LDA(At, 1, 0);
            PG8_WAIT_L(0); PG8_BAR; PG8_MMA(0, 0, At, B0); PG8_MMA(0, 1, At, B1); PG8_BAR; PG8_SCHED;
            PG8_STAGE(PG8_SB(1, 0), b3, voffB); PG8_STAGE(PG8_SB(1, 1), b3 + hstepB, voffB); PG8_STAGE(PG8_SA(1, 0), a3, voffA);
            PG8_WAIT_V(6); PG8_BAR; PG8_BAR; PG8_SCHED;
            } else {
            PG8_LDB(B0, 0, 0); PG8_LDB(B1, 0, 1); PG8_SCHED; PG8_LDA(At, 0, 0); PG8_STAGE(PG8_SA(1, 1), a1 + hstepA, voffA);
            PG8_WAIT_V(8); PG8_WAIT_L(0); PG8_BAR; PG8_MMA(0, 0, At, B0); PG8_MMA(0, 1, At, B1); PG8_BAR; PG8_SCHED;
            PG8_LDA(At, 0, 1); PG8_STAGE(PG8_SB(0, 0), b2, voffB); PG8_STAGE(PG8_SB(0, 1), b2 + hstepB, voffB); PG8_STAGE(PG8_SA(0, 0), a2, voffA);
            PG8_WAIT_V(8); PG8_WAIT_L(0); PG8_BAR; PG8_MMA(1, 0, At, B0); PG8_MMA(1, 1, At, B1); PG8_BAR; PG8_SCHED;
            PG8_LDB(B0, 1, 0); PG8_LDB(B1, 1, 1); PG8_SCHED; PG8_LDA(At, 1, 0); PG8_STAGE(PG8_SA(0, 1), a2 + hstepA, voffA);
            PG8_WAIT_V(8); PG8_WAIT_L(0); PG8_BAR; PG8_MMA(0, 0, At, B0); PG8_MMA(0, 1, At, B1); PG8_BAR; PG8_SCHED;
            PG8_LDA(At, 1, 1); PG8_STAGE(PG8_SB(1, 0), b3, voffB); PG8_STAGE(PG8_SB(1, 1), b3 + hstepB, voffB); PG8_STAGE(PG8_SA(1, 0), a3, voffA);
            PG8_WAIT_V(8); PG8_WAIT_L(0); PG8_BAR; PG8_MMA(1, 0, At, B0); PG8_MMA(1, 1, At, B1); PG8_BAR; PG8_SCHED;
            }
        }
        if (wr == 0) PG8_BAR;
        if constexpr (!Epi::AFTER_DRAIN) E(acc, cur, wr, wc, fr, fq);
        if (!has_next) break;
        if (!Epi::keep_acc(cur)) {
#pragma unroll
        for (int a = 0; a < 2; ++a)
#pragma unroll
            for (int b = 0; b < 2; ++b)
#pragma unroll
                for (int m = 0; m < 4; ++m)
#pragma unroll
                    for (int n = 0; n < 2; ++n) acc[a][b][m][n] = (f32x4){0.f, 0.f, 0.f, 0.f};
        }
        cur = nxt; cA = nA; cB = nB; ++ui;
        if (wr == 1) PG8_BAR;
    }
    PG8_WAIT_V(0);
    PG8_BAR;
    if constexpr (Epi::AFTER_DRAIN) E.fused(acc, cur, wr, wc, fr, fq, lds, wid, lane);
#undef PG8_SA
#undef PG8_SB
#undef PG8_STAGE
#undef PG8_LDA
#undef PG8_LDB
#undef PG8_MMA
#undef PG8_WAIT_V
#undef PG8_WAIT_L
#undef PG8_BAR
#undef PG8_SCHED
}
}
using pg8::Unit;
typedef f32x4 Acc[2][2][4][2];

struct SchedP1 { const char* A; const char* B; int G, c; unsigned* cnt;
    __device__ __forceinline__ void ready(const Unit& u) const {
        if (cnt == nullptr || u.pn < 14) return;
        if (threadIdx.x < 64) { unsigned sp = 0;
            while ((unsigned)__builtin_amdgcn_readfirstlane(__hip_atomic_load(cnt + 32 * u.pn, __ATOMIC_RELAXED, __HIP_MEMORY_SCOPE_AGENT)) < 128u) { __builtin_amdgcn_s_sleep(2); if (++sp > (1u << 22)) break; }
            __builtin_amdgcn_fence(__ATOMIC_ACQUIRE, "agent"); asm volatile("s_waitcnt vmcnt(0)" ::: "memory"); }
        asm volatile("" ::: "memory"); __builtin_amdgcn_s_barrier(); asm volatile("" ::: "memory");
    }
    __device__ __forceinline__ bool next(int i, Unit& u) const {
        const int L = i * G + c; if (L >= 1536 + 24) return false;
        int pm, pn; if (L < 1536) pg8::tile_of(L, 32, 48, pm, pn); else { pm = 32; pn = L - 1536; }
        u.A = A + (size_t)pm * 256 * D * 2; u.B = B + (size_t)pn * 256 * D * 2; u.nt = D / 64; u.kind = 0; u.pm = pm; u.pn = pn; return true; } };
struct SchedP3 { const char* A; const char* B; int G, c;
    __device__ __forceinline__ void ready(const Unit&) const {}
    __device__ __forceinline__ bool next(int i, Unit& u) const {
        const int L = (i >> 1) * G + c, part = i & 1; if (L >= 256) return false;
        int pm, pn; pg8::tile_of(L, 32, 8, pm, pn);
        u.A = A + ((size_t)pm * 256 * 4096 + (part ? 2048 : (pn >> 1) * 512)) * 2; u.B = B + ((size_t)pn * 256 * KCAT + (part ? 512 : 0)) * 2;
        u.nt = part ? 32 : 8; u.kind = part; u.pm = pm; u.pn = pn; return true; } };
struct SchedG { const char* A; const char* B; int G, c, nM, nN, K;
    __device__ __forceinline__ void ready(const Unit&) const {}
    __device__ __forceinline__ bool next(int i, Unit& u) const {
        const int L = i * G + c; if (L >= nM * nN) return false;
        int pm, pn; pg8::tile_of(L, nM, nN, pm, pn);
        u.A = A + (size_t)pm * 256 * K * 2; u.B = B + (size_t)pn * 256 * K * 2; u.nt = K / 64; u.kind = 0; u.pm = pm; u.pn = pn; return true; } };

struct SchedP5a { const char* A; const char* B; int G, c;
    __device__ __forceinline__ void ready(const Unit&) const {}
    __device__ __forceinline__ bool next(int i, Unit& u) const {
        const int L = i * G + c; if (L >= (G == 256 ? 1280 : 32 * 44)) return false;
        int pm, pn; pg8::tile_of(L, 32, 44, pm, pn);
        u.A = A + (size_t)pm * 256 * D * 2; u.B = B + (size_t)pn * 256 * D * 2; u.nt = D / 64; u.kind = 0; u.pm = pm; u.pn = pn; return true; } };
struct SchedP5b { const char* A; const char* B; int c;
    __device__ __forceinline__ void ready(const Unit&) const {}
    __device__ __forceinline__ bool next(int i, Unit& u) const {
        if (i > 0) return false;
        const int h = c >> 7; int pm, pn; pg8::tile_of(1280 + (c & 127), 32, 44, pm, pn);
        u.A = A + ((size_t)pm * 256 + h * 128) * D * 2; u.B = B + (size_t)pn * 256 * D * 2; u.nt = D / 64; u.kind = 4 | h; u.pm = pm; u.pn = pn; return true; } };

struct EpiP1 { static constexpr bool AFTER_DRAIN = false; static __device__ __forceinline__ bool keep_acc(const Unit&) { return false; } bf16_t* U; bf16_t* Sb; bf16_t* GB; bf16_t* GATES; const float* b_gate;
    __device__ __forceinline__ void operator()(const Acc& acc, const Unit& u, int wr, int wc, int fr, int fq) const {
        const int row0 = u.pm * 256 + wr * 64 + fr, cl = wc * 32 + 8 * fq, pn = u.pn;
        if (pn < 8 || (pn >= 24 && pn < 32)) {
            bf16_t* base = (pn < 8) ? U + pn * 256 : GB + (pn - 24) * 256;
#pragma unroll
            for (int ai = 0; ai < 2; ++ai)
#pragma unroll
                for (int m = 0; m < 4; ++m) { bf16_t* rowp = base + (size_t)(row0 + ai * 128 + m * 16) * D + cl;
#pragma unroll
                    for (int bj = 0; bj < 2; ++bj) NT_ST(pack8(acc[ai][bj][m][0], acc[ai][bj][m][1]), (u32x4*)(rowp + bj * 128)); }
        } else if (pn < 24) {
            bf16_t* base = Sb + (pn - 8) * 128 + cl;
#pragma unroll
            for (int ai = 0; ai < 2; ++ai)
#pragma unroll
                for (int m = 0; m < 4; ++m)
                    NT_ST(pack8(acc[ai][0][m][0] * acc[ai][1][m][0], acc[ai][0][m][1] * acc[ai][1][m][1]), (u32x4*)(base + (size_t)(row0 + ai * 128 + m * 16) * D));
        } else {
            const int col0 = (pn - 32) * 256 + cl;
            f32x4 bv[2][2];
#pragma unroll
            for (int bj = 0; bj < 2; ++bj)
#pragma unroll
                for (int n = 0; n < 2; ++n) bv[bj][n] = *(const f32x4*)(b_gate + col0 + bj * 128 + 4 * n);
#pragma unroll
            for (int ai = 0; ai < 2; ++ai)
#pragma unroll
                for (int m = 0; m < 4; ++m) { bf16_t* rowp = GATES + (size_t)(row0 + ai * 128 + m * 16) * 4096 + col0;
#pragma unroll
                    for (int bj = 0; bj < 2; ++bj) { f32x4 v0 = acc[ai][bj][m][0] + bv[bj][0], v1 = acc[ai][bj][m][1] + bv[bj][1];
#pragma unroll
                        for (int j = 0; j < 4; ++j) { v0[j] = sigmoidf_fast(v0[j]); v1[j] = sigmoidf_fast(v1[j]); }
                        NT_ST(pack8(v0, v1), (u32x4*)(rowp + bj * 128)); } }
        }
    }
};
struct EpiP3 { static constexpr bool AFTER_DRAIN = false; static __device__ __forceinline__ bool keep_acc(const Unit& u) { return u.kind == 0; }
    const bf16_t* GATES; bf16_t* Z;
    __device__ __forceinline__ void operator()(Acc& acc, const Unit& u, int wr, int wc, int fr, int fq) const {
        const int row0 = u.pm * 256 + wr * 64 + fr, col0 = u.pn * 256 + wc * 32 + 8 * fq;
        const bool k0 = (u.kind == 0);
        u32x4 gbuf[2][4];
#define P3_LOAD(buf, g) do { const size_t row_ = (size_t)(row0 + ((g) >> 2) * 128 + ((g) & 3) * 16); const bf16_t* gp_ = GATES + row_ * 4096 + col0; \
            gbuf[buf][0] = NT_LD((const u32x4*)(gp_ + 2048)); gbuf[buf][1] = NT_LD((const u32x4*)(gp_ + 2048 + 128)); \
            if (k0) { gbuf[buf][2] = NT_LD((const u32x4*)(gp_)); gbuf[buf][3] = NT_LD((const u32x4*)(gp_ + 128)); } } while (0)
        P3_LOAD(0, 0);
#pragma unroll
        for (int g = 0; g < 8; ++g) { const int ai = g >> 2, m = g & 3; const size_t row = (size_t)(row0 + ai * 128 + m * 16);
            if (g + 1 < 8) P3_LOAD((g + 1) & 1, g + 1);
#pragma unroll
            for (int bj = 0; bj < 2; ++bj) { const int col = col0 + bj * 128;
                float gb[8]; unpack8(gbuf[g & 1][bj], gb);
#pragma unroll
                for (int j = 0; j < 8; ++j) gb[j] = fmaxf(gb[j], 1e-30f);
                if (k0) {
                    float ga[8]; unpack8(gbuf[g & 1][2 + bj], ga);
#pragma unroll
                    for (int j = 0; j < 4; ++j) { acc[ai][bj][m][0][j] *= ga[j] * __builtin_amdgcn_rcpf(gb[j]); acc[ai][bj][m][1][j] *= ga[4 + j] * __builtin_amdgcn_rcpf(gb[4 + j]); }
                } else {
                    f32x4 v0 = acc[ai][bj][m][0], v1 = acc[ai][bj][m][1];
#pragma unroll
                    for (int j = 0; j < 4; ++j) { v0[j] *= gb[j]; v1[j] *= gb[4 + j]; }
                    *(u32x4*)(Z + row * D + col) = pack8(v0, v1); } }
            asm volatile("" ::: "memory"); }
#undef P3_LOAD
    }
};
struct EpiP4 { static constexpr bool AFTER_DRAIN = false; static __device__ __forceinline__ bool keep_acc(const Unit&) { return false; } const float* base; bf16_t* hb; float* ssq;
    __device__ __forceinline__ void operator()(const Acc& acc, const Unit& u, int wr, int wc, int fr, int fq) const {
        const int row0 = u.pm * 256 + wr * 64 + fr, col0 = u.pn * 256 + wc * 32 + 8 * fq;
        f32x4 xbuf[2][4];
#define P4_LOAD(buf, g) do { const float* xp_ = base + (size_t)(row0 + ((g) >> 2) * 128 + ((g) & 3) * 16) * D + col0; \
            xbuf[buf][0] = NT_LD((const f32x4*)(xp_)); xbuf[buf][1] = NT_LD((const f32x4*)(xp_ + 4)); xbuf[buf][2] = NT_LD((const f32x4*)(xp_ + 128)); xbuf[buf][3] = NT_LD((const f32x4*)(xp_ + 132)); } while (0)
        P4_LOAD(0, 0);
#pragma unroll
        for (int g = 0; g < 8; ++g) { const int ai = g >> 2, m = g & 3; const size_t row = (size_t)(row0 + ai * 128 + m * 16); float s = 0.f;
            if (g + 1 < 8) P4_LOAD((g + 1) & 1, g + 1);
#pragma unroll
            for (int bj = 0; bj < 2; ++bj) { const size_t off = row * D + col0 + bj * 128;
                const f32x4 v0 = xbuf[g & 1][2 * bj] + acc[ai][bj][m][0], v1 = xbuf[g & 1][2 * bj + 1] + acc[ai][bj][m][1];
                *(u32x4*)(hb + off) = pack8(v0, v1);
                s += (v0[0] * v0[0] + v0[1] * v0[1]) + (v0[2] * v0[2] + v0[3] * v0[3]) + (v1[0] * v1[0] + v1[1] * v1[1]) + (v1[2] * v1[2] + v1[3] * v1[3]); }
            s += __shfl_xor(s, 16); s += __shfl_xor(s, 32);
            if (fq == 0) ssq[row * 32 + u.pn * 4 + wc] = s;
            asm volatile("" ::: "memory"); }
#undef P4_LOAD
    }
};
struct EpiP6F { static constexpr bool AFTER_DRAIN = true; static __device__ __forceinline__ bool keep_acc(const Unit&) { return false; } const bf16_t* h1b; float* out; const float* gfin; unsigned* xbuf; unsigned* cnt;
    __device__ __forceinline__ void operator()(const Acc&, const Unit&, int, int, int, int) const {}
    __device__ __forceinline__ void fused(Acc& acc, const Unit& u, int wr, int wc, int fr, int fq, LAS unsigned char* lds, int wid, int lane) const {
        LAS float* P = (LAS float*)lds;
        LAS float* S = (LAS float*)(lds + 4096);
        const int row0 = u.pm * 256 + wr * 64 + fr, col0 = u.pn * 256 + wc * 32 + 8 * fq;
#pragma unroll
        for (int ai = 0; ai < 2; ++ai)
#pragma unroll
            for (int m = 0; m < 4; ++m) { const size_t row = (size_t)(row0 + ai * 128 + m * 16); float s = 0.f;
#pragma unroll
                for (int bj = 0; bj < 2; ++bj) { float h[8]; unpack8(NT_LD((const u32x4*)(h1b + row * D + col0 + bj * 128)), h);
#pragma unroll
                    for (int j = 0; j < 4; ++j) { acc[ai][bj][m][0][j] += h[j]; acc[ai][bj][m][1][j] += h[4 + j]; }
                    const f32x4 v0 = acc[ai][bj][m][0], v1 = acc[ai][bj][m][1];
                    s += (v0[0] * v0[0] + v0[1] * v0[1]) + (v0[2] * v0[2] + v0[3] * v0[3]) + (v1[0] * v1[0] + v1[1] * v1[1]) + (v1[2] * v1[2] + v1[3] * v1[3]); }
                s += __shfl_xor(s, 16); s += __shfl_xor(s, 32);
                if (fq == 0) P[(ai * 128 + wr * 64 + m * 16 + fr) * 4 + wc] = s; }
        asm volatile("s_waitcnt lgkmcnt(0)" ::: "memory"); __builtin_amdgcn_s_barrier(); asm volatile("" ::: "memory");
        const int rl = wid * 32 + (lane & 31);
        if (lane < 32) { const float t = (P[rl * 4 + 0] + P[rl * 4 + 1]) + (P[rl * 4 + 2] + P[rl * 4 + 3]);
            __hip_atomic_store(xbuf + ((size_t)(u.pm * 256 + rl) * 8 + u.pn), __float_as_uint(t), __ATOMIC_RELAXED, __HIP_MEMORY_SCOPE_AGENT); }
        asm volatile("s_waitcnt vmcnt(0)" ::: "memory");
        if (lane == 0) __hip_atomic_fetch_add(cnt + 64 * u.pm, 1u, __ATOMIC_RELAXED, __HIP_MEMORY_SCOPE_AGENT);
        if (wid == 0) { unsigned sp = 0;
            while ((unsigned)__builtin_amdgcn_readfirstlane(__hip_atomic_load(cnt + 64 * u.pm, __ATOMIC_RELAXED, __HIP_MEMORY_SCOPE_AGENT)) < 64u) { __builtin_amdgcn_s_sleep(2); if (++sp > (1u << 22)) break; }
            __builtin_amdgcn_fence(__ATOMIC_ACQUIRE, "agent"); }
        asm volatile("s_waitcnt vmcnt(0) lgkmcnt(0)" ::: "memory"); __builtin_amdgcn_s_barrier(); asm volatile("" ::: "memory");
        if (lane < 32) { const unsigned* slot = xbuf + (size_t)(u.pm * 256 + rl) * 8; float t = 0.f;
#pragma unroll
            for (int k = 0; k < 8; ++k) t += __uint_as_float(__hip_atomic_load(slot + k, __ATOMIC_RELAXED, __HIP_MEMORY_SCOPE_AGENT));
            S[rl] = 1.0f / sqrtf(t * (1.0f / D) + EPS); }
        asm volatile("s_waitcnt lgkmcnt(0)" ::: "memory"); __builtin_amdgcn_s_barrier(); asm volatile("" ::: "memory");
        f32x4 gv[2][2];
#pragma unroll
        for (int bj = 0; bj < 2; ++bj)
#pragma unroll
            for (int n = 0; n < 2; ++n) gv[bj][n] = *(const f32x4*)(gfin + col0 + bj * 128 + 4 * n);
#pragma unroll
        for (int ai = 0; ai < 2; ++ai)
#pragma unroll
            for (int m = 0; m < 4; ++m) { const int rloc = ai * 128 + wr * 64 + m * 16 + fr; const float rstd = S[rloc]; float* rowp = out + (size_t)(u.pm * 256 + rloc) * D + col0;
#pragma unroll
                for (int bj = 0; bj < 2; ++bj) { NT_ST(acc[ai][bj][m][0] * rstd * gv[bj][0], (f32x4*)(rowp + bj * 128)); NT_ST(acc[ai][bj][m][1] * rstd * gv[bj][1], (f32x4*)(rowp + bj * 128 + 4)); } }
    }
};
struct EpiP5 { static constexpr bool AFTER_DRAIN = false; static __device__ __forceinline__ bool keep_acc(const Unit&) { return false; } const float* ssq; bf16_t* ACT;
    __device__ __forceinline__ void operator()(const Acc& acc, const Unit& u, int wr, int wc, int fr, int fq) const {
        const bool half = (u.kind & 4) != 0;
        const int row0 = u.pm * 256 + (half ? (u.kind & 1) * 128 : 0) + wr * 64 + fr, col0 = u.pn * 128 + wc * 32 + 8 * fq;
#pragma unroll
        for (int ai = 0; ai < 2; ++ai) { if (ai == 1 && half) break;
#pragma unroll
            for (int m = 0; m < 4; ++m) { const size_t row = (size_t)(row0 + ai * 128 + m * 16);
                const f32x4 p0 = *(const f32x4*)(ssq + row * 32 + 8 * fq), p1 = *(const f32x4*)(ssq + row * 32 + 8 * fq + 4);
                float s = ((p0[0] + p0[1]) + (p0[2] + p0[3])) + ((p1[0] + p1[1]) + (p1[2] + p1[3]));
                s += __shfl_xor(s, 16); s += __shfl_xor(s, 32);
                const float rstd = __builtin_amdgcn_rsqf(s * (1.0f / D) + EPS);
                f32x4 o[2];
#pragma unroll
                for (int n = 0; n < 2; ++n)
#pragma unroll
                    for (int j = 0; j < 4; ++j) { const float g = acc[ai][0][m][n][j] * rstd, up = acc[ai][1][m][n][j] * rstd; o[n][j] = g * sigmoidf_fast(g) * up; }
                NT_ST(pack8(o[0], o[1]), (u32x4*)(ACT + row * FF + col0)); } }
    }
};

__device__ __forceinline__ void tr_item(const float* __restrict__ W, int N, int k0, int n0, bf16_t* WT, int ldT, int drow0, int kd0, const float* rs, const float* cs, LAS float* scr, int lane, bool wt = false) {
    const int r = lane >> 4, q = lane & 15;
    f32x4 v[16];
#pragma unroll
    for (int j = 0; j < 16; ++j) v[j] = __builtin_nontemporal_load((const f32x4*)(W + (size_t)(k0 + 4 * j + r) * N + n0 + 4 * q));
#pragma unroll
    for (int j = 0; j < 16; ++j) { LAS float* d = scr + (4 * j + r) * 65 + 4 * q; d[0] = v[j][0]; d[1] = v[j][1]; d[2] = v[j][2]; d[3] = v[j][3]; }
    asm volatile("s_waitcnt lgkmcnt(0)" ::: "memory");
    const int c = lane & 7;
    f32x4 r0 = {1.f, 1.f, 1.f, 1.f}, r1 = {1.f, 1.f, 1.f, 1.f};
    if (rs) { r0 = *(const f32x4*)(rs + k0 + 8 * c); r1 = *(const f32x4*)(rs + k0 + 8 * c + 4); }
#pragma unroll
    for (int j = 0; j < 8; ++j) { const int n = (lane >> 3) + 8 * j; const LAS float* sp = scr + (8 * c) * 65 + n; const float sc = cs ? cs[n0 + n] : 1.0f;
        u32x4 o; o.x = cvt_pk_bf16(sp[0 * 65] * r0[0] * sc, sp[1 * 65] * r0[1] * sc); o.y = cvt_pk_bf16(sp[2 * 65] * r0[2] * sc, sp[3 * 65] * r0[3] * sc);
        o.z = cvt_pk_bf16(sp[4 * 65] * r1[0] * sc, sp[5 * 65] * r1[1] * sc); o.w = cvt_pk_bf16(sp[6 * 65] * r1[2] * sc, sp[7 * 65] * r1[3] * sc);
        if (wt) st16_wt(WT + (size_t)(drow0 + n) * ldT + kd0 + k0 + 8 * c, o); else *(u32x4*)(WT + (size_t)(drow0 + n) * ldT + kd0 + k0 + 8 * c) = o; }
    asm volatile("s_waitcnt lgkmcnt(0)" ::: "memory");
}
__device__ __forceinline__ void rms_row_to_bf16(const float* src, const float* g, bf16_t* dst, int lane) {
    u32x4* o = (u32x4*)dst;
    if (!src) {
#pragma unroll
        for (int j = 0; j < 4; ++j) o[lane + 64 * j] = (u32x4){0u, 0u, 0u, 0u};
        return; }
    const f32x4* xr = (const f32x4*)src; const f32x4* gr = (const f32x4*)g;
    f32x4 v[4][2]; float s = 0.f;
#pragma unroll
    for (int j = 0; j < 4; ++j)
#pragma unroll
        for (int h = 0; h < 2; ++h) { v[j][h] = NT_LD(xr + 2 * (lane + 64 * j) + h); s += (v[j][h][0] * v[j][h][0] + v[j][h][1] * v[j][h][1]) + (v[j][h][2] * v[j][h][2] + v[j][h][3] * v[j][h][3]); }
    const float rstd = 1.0f / sqrtf(wave_sum(s) * (1.0f / D) + EPS);
#pragma unroll
    for (int j = 0; j < 4; ++j) { const f32x4 g0 = gr[2 * (lane + 64 * j)], g1 = gr[2 * (lane + 64 * j) + 1];
        o[lane + 64 * j] = pack8(v[j][0] * rstd * g0, v[j][1] * rstd * g1); }
}


__device__ __forceinline__ int seq_row(int b, int l) { return l >= NMETA ? b * SEQ + (l - NMETA) : MX + l; }
template <int W> __device__ __forceinline__ void pool_task(const bf16_t* U, bf16_t* ACT2, int b, int t0, int col) {
    constexpr int NR = W + 7;
    u32x4 raw[NR];
#pragma unroll
    for (int k = 0; k < NR; ++k) raw[k] = *(const u32x4*)(U + (size_t)seq_row(b, t0 + NMETA - (W - 1) + k) * D + col);
    float sum[8];
#pragma unroll
    for (int j = 0; j < 8; ++j) sum[j] = 0.f;
#pragma unroll
    for (int k = 0; k < W - 1; ++k) { float f[8]; unpack8(raw[k], f);
#pragma unroll
        for (int j = 0; j < 8; ++j) sum[j] += f[j]; }
    const float inv = 1.0f / (float)W;
#pragma unroll
    for (int r = 0; r < 8; ++r) { float fn[8], fo[8]; unpack8(raw[W - 1 + r], fn); unpack8(raw[r], fo);
        f32x4 o0, o1;
#pragma unroll
        for (int j = 0; j < 8; ++j) sum[j] += fn[j];
#pragma unroll
        for (int j = 0; j < 4; ++j) { o0[j] = sum[j] * inv - fn[j]; o1[j] = sum[4 + j] * inv - fn[4 + j]; }
#pragma unroll
        for (int j = 0; j < 8; ++j) sum[j] -= fo[j];
        *(u32x4*)(ACT2 + (size_t)(b * SEQ + t0 + r) * 4096 + col) = pack8(o0, o1); }
}
__device__ __forceinline__ void conv_task(const bf16_t* Sb, const bf16_t* GB, const float* conv_w, bf16_t* ACT2, int b, int t0, int col) {
    u32x4 sr[10], gr[8];
#pragma unroll
    for (int k = 0; k < 10; ++k) sr[k] = *(const u32x4*)(Sb + (size_t)seq_row(b, t0 + NMETA - 2 + k) * D + col);
#pragma unroll
    for (int r = 0; r < 8; ++r) gr[r] = *(const u32x4*)(GB + (size_t)(b * SEQ + t0 + r) * D + col);
    float w0[8], w1[8], w2[8];
#pragma unroll
    for (int h = 0; h < 2; ++h) { const f32x4 a = *(const f32x4*)(conv_w + col + 4 * h), bb = *(const f32x4*)(conv_w + D + col + 4 * h), c = *(const f32x4*)(conv_w + 2 * D + col + 4 * h);
#pragma unroll
        for (int j = 0; j < 4; ++j) { w0[4 * h + j] = a[j]; w1[4 * h + j] = bb[j]; w2[4 * h + j] = c[j]; } }
#pragma unroll
    for (int r = 0; r < 8; ++r) { float s0[8], s1[8], s2[8], g[8]; unpack8(sr[r], s0); unpack8(sr[r + 1], s1); unpack8(sr[r + 2], s2); unpack8(gr[r], g);
        f32x4 o0, o1;
#pragma unroll
        for (int j = 0; j < 4; ++j) { o0[j] = g[j] * (w0[j] * s0[j] + w1[j] * s1[j] + w2[j] * s2[j]); o1[j] = g[4 + j] * (w0[4 + j] * s0[4 + j] + w1[4 + j] * s1[4 + j] + w2[4 + j] * s2[4 + j]); }
        *(u32x4*)(ACT2 + (size_t)(b * SEQ + t0 + r) * 4096 + 2048 + col) = pack8(o0, o1); }
}

#define XB_TMO      128
#define XB_XCNT(j)  (256  + 64 * (j))
#define XB_XSUB(j)  (1280 + 64 * (j))
#define XB_XGEN(j)  (2304 + 64 * (j))
#define XB_TOP      3328
#define XB_TOPGEN   3392
#define XCD_BAR_WORDS 3456
#define XB_SPIN_CAP (1u << 18)
__device__ __forceinline__ unsigned xb_ld(unsigned* p)              { return __hip_atomic_load(p, __ATOMIC_RELAXED, __HIP_MEMORY_SCOPE_AGENT); }
__device__ __forceinline__ unsigned xb_add(unsigned* p, unsigned v) { return __hip_atomic_fetch_add(p, v, __ATOMIC_RELAXED, __HIP_MEMORY_SCOPE_AGENT); }
__device__ __forceinline__ unsigned xb_xcc_id() { return (unsigned)__builtin_amdgcn_s_getreg((3 << 11) | 20) & 0xFu; }
#define XB_SPIN(cond, bar) do { unsigned _sp = 0; while (cond) { __builtin_amdgcn_s_sleep(1); \
    if ((++_sp & 255u) == 0u) { if (xb_ld(&(bar)[XB_TMO])) break; if (_sp > XB_SPIN_CAP) { atomicAdd(&(bar)[XB_TMO], 1u); break; } } } } while (0)
struct XcdBarrier { unsigned* bar; unsigned x; volatile LAS unsigned* st; };
__device__ __forceinline__ XcdBarrier xcd_barrier_post(unsigned* bar, volatile LAS unsigned* st) {
    XcdBarrier b; b.bar = bar; b.x = xb_xcc_id(); b.st = st;
    if (threadIdx.x == 0) (void)xb_add(&bar[XB_XCNT(b.x)], 1u);
    return b;
}
__device__ __forceinline__ void xcd_barrier_complete(unsigned* bar, unsigned x, unsigned& nloc, unsigned& nx) {
    const unsigned G = gridDim.x * gridDim.y * gridDim.z;
    unsigned sum, cnt, mine, sp = 0u;
    for (;;) {
        sum = 0u; cnt = 0u; mine = 0u;
#pragma unroll
        for (unsigned j = 0; j < 16; ++j) { const unsigned c = xb_ld(&bar[XB_XCNT(j)]); sum += c; cnt += (c > 0u) ? 1u : 0u; mine = (j == x) ? c : mine; }
        if (sum == G) break;
        __builtin_amdgcn_s_sleep(1);
        if ((++sp & 255u) == 0u) { if (xb_ld(&bar[XB_TMO])) break; if (sp > XB_SPIN_CAP) { atomicAdd(&bar[XB_TMO], 1u); break; } }
    }
    nloc = mine > 0u ? mine : 1u; nx = cnt > 0u ? cnt : 1u;
}
__device__ __forceinline__ void xcd_barrier(const XcdBarrier& b) {
    asm volatile("s_waitcnt vmcnt(0)" ::: "memory");
    __syncthreads();
    if (threadIdx.x == 0) {
        unsigned* bar = b.bar;
        __builtin_amdgcn_s_waitcnt(0);
        unsigned nloc = b.st[0], nx = b.st[1];
        if (nloc == 0u) { xcd_barrier_complete(bar, b.x, nloc, nx); b.st[0] = nloc; b.st[1] = nx; }
        const unsigned old = xb_add(&bar[XB_XSUB(b.x)], 1u);
        const unsigned gen = old / nloc;
        if (old + 1u == (gen + 1u) * nloc) {
            __builtin_amdgcn_fence(__ATOMIC_RELEASE, "agent");
            asm volatile("s_waitcnt vmcnt(0)" ::: "memory");
            const unsigned og = xb_add(&bar[XB_TOP], 1u);
            const unsigned tg = og / nx;
            if (og + 1u == (tg + 1u) * nx) xb_add(&bar[XB_TOPGEN], 1u);
            else XB_SPIN(xb_ld(&bar[XB_TOPGEN]) == tg, bar);
            __builtin_amdgcn_fence(__ATOMIC_ACQUIRE, "agent");
            xb_add(&bar[XB_XGEN(b.x)], 1u);
            asm volatile("s_waitcnt vmcnt(0)" ::: "memory");
        } else {
            XB_SPIN(xb_ld(&bar[XB_XGEN(b.x)]) == gen, bar);
            __builtin_amdgcn_fence(__ATOMIC_ACQUIRE, "agent");
            asm volatile("s_waitcnt vmcnt(0)" ::: "memory");
        }
    }
    __syncthreads();
}

struct Args { const float* in[14]; float* out; unsigned char* ws; int ph_lo, ph_hi; };

__global__ void __launch_bounds__(512, 2) fwd_megakernel(Args a) {
    extern __shared__ __attribute__((aligned(16))) unsigned char lds_raw[];
    LAS unsigned char* lds = (LAS unsigned char*)lds_raw;
    cg::grid_group grid = cg::this_grid();
    const int tid = threadIdx.x, lane = tid & 63, wave = __builtin_amdgcn_readfirstlane(tid >> 6);
    const int G = gridDim.x, bx = blockIdx.x;
    const int vcu = (G % 8 == 0) ? (bx % 8) * (G / 8) + bx / 8 : bx;
    const int gw = vcu * 8 + wave, NGW = G * 8;
    unsigned char* ws = a.ws;
    const float* x = a.in[0]; const float* meta = a.in[1]; const float* g_mix = a.in[2]; const float* w_in = a.in[3]; const float* b_gate = a.in[4];
    const float* pool_w = a.in[5]; const float* pool_scale = a.in[6]; const float* conv_w = a.in[7]; const float* conv_out_w = a.in[8]; const float* w_o = a.in[9];
    const float* g_ffn = a.in[10]; const float* w_gu = a.in[11]; const float* w_down = a.in[12]; const float* g_final = a.in[13];
    float* out = a.out;
    bf16_t* WdT = (bf16_t*)(ws + WS_WD); bf16_t* WguT = (bf16_t*)(ws + WS_WGU); bf16_t* WoT = (bf16_t*)(ws + WS_WO); bf16_t* Bcat = (bf16_t*)(ws + WS_BCAT); bf16_t* WinT = (bf16_t*)(ws + WS_WIN);
    bf16_t* HN = (bf16_t*)(ws + WS_HN); bf16_t* U = (bf16_t*)(ws + WS_U); bf16_t* Sb = (bf16_t*)(ws + WS_S); bf16_t* GB = (bf16_t*)(ws + WS_GB); bf16_t* GATES = (bf16_t*)(ws + WS_GATES);
    bf16_t* ACT2 = (bf16_t*)(ws + WS_ACT2); float* ZA = (float*)(ws + WS_ZA); bf16_t* Z = (bf16_t*)(ws + WS_Z); bf16_t* H1B = (bf16_t*)(ws + WS_H1B); bf16_t* ACT = (bf16_t*)(ws + WS_ACT);
    float* SSQ1 = (float*)(ws + WS_SSQ1); float* SSQ2 = (float*)(ws + WS_SSQ2);

    const int lo = a.ph_lo, hi = a.ph_hi;
    if (lo < 0) grid.sync();
    XcdBarrier xbar; xbar.bar = (unsigned*)ws; xbar.x = 0; xbar.st = nullptr;
#if MK_N_LAUNCHES == 1
    { volatile LAS unsigned* st = (volatile LAS unsigned*)(lds + LDS_BYTES - 64); if (tid < 16) st[tid] = 0u; __syncthreads(); xbar = xcd_barrier_post((unsigned*)ws, st); }
#endif
#define IN(k) (lo <= (k) && (k) < hi)
#if MK_N_LAUNCHES == 1
#define GSYNC() xcd_barrier(xbar)
#else
#define GSYNC() do {} while (0)
#endif
#define SEAM(k) do { if (IN(k) && IN((k) + 1)) GSYNC(); } while (0)

    constexpr int I_WIN = 32 * 192, I_WGU = 32 * 176, I_WO = 32 * 32, I_CO = 32 * 32, I_PW = 4 * 8 * 8, I_WD = 88 * 32;
    constexpr int IT_MID = I_WIN + I_WGU + I_WO + I_CO + I_PW, NITEMS = IT_MID + I_WD;
    constexpr int G_GEMM = 224, P0_TILES = 14;
    const bool split_conv = (G == 256) && (MK_N_LAUNCHES == 1);
#define CONVERT_ITEMS(lo_, hi_, w_, nw_, cnt_) do { int lane = tid & 63, wv_ = wave; asm volatile("" : "+v"(lane), "+s"(wv_));   \
        LAS float* scr = (LAS float*)(lds + wv_ * 16640); unsigned* const cntp_ = (cnt_); \
        for (int it = (lo_) + (w_); it < (hi_); it += (nw_)) { int r = it; \
            if (r < I_WIN) {   \
                const int t_ = r >> 7, kb = (r & 127) >> 2, sub = r & 3; \
                const int nb = t_ < 8 ? 4 * t_ + sub : (t_ < 24 ? (sub < 2 ? 64 + 2 * (t_ - 8) + sub : 96 + 2 * (t_ - 8) + (sub - 2)) : (t_ < 32 ? 32 + 4 * (t_ - 24) + sub : 128 + 4 * (t_ - 32) + sub)); \
                const int n0 = 64 * nb; int drow; \
                if (n0 < 2048) drow = n0; \
                else if (n0 < 4096) drow = 6144 + (n0 - 2048); \
                else if (n0 < 6144) { const int cc = n0 - 4096; drow = 2048 + 256 * (cc >> 7) + (cc & 127); } \
                else if (n0 < 8192) { const int cc = n0 - 6144; drow = 2048 + 256 * (cc >> 7) + 128 + (cc & 127); } \
                else drow = n0; \
                tr_item(w_in, NIN, 64 * kb, n0, WinT, D, drow, 0, nullptr, nullptr, scr, lane, cntp_ != nullptr); \
                if (cntp_) { asm volatile("s_waitcnt vmcnt(0)" ::: "memory"); if (lane == 0) __hip_atomic_fetch_add(cntp_ + 32 * t_, 1u, __ATOMIC_RELAXED, __HIP_MEMORY_SCOPE_AGENT); } \
                continue; } r -= I_WIN; \
            if (r < I_WGU) { const int kb = r / 176, nb = r % 176, n0 = 64 * nb; int drow; \
                if (n0 < FF) drow = 256 * (n0 >> 7) + (n0 & 127); else { const int cc = n0 - FF; drow = 256 * (cc >> 7) + 128 + (cc & 127); } \
                tr_item(w_gu, NGU, 64 * kb, n0, WguT, D, drow, 0, g_ffn, nullptr, scr, lane); continue; } r -= I_WGU; \
            if (r < I_WO) { const int kb = r / 32, nb = r % 32; tr_item(w_o, D, 64 * kb, 64 * nb, WoT, D, 64 * nb, 0, nullptr, nullptr, scr, lane); continue; } r -= I_WO; \
            if (r < I_CO) { const int kb = r / 32, nb = r % 32; tr_item(conv_out_w, D, 64 * kb, 64 * nb, Bcat, KCAT, 64 * nb, 512, nullptr, nullptr, scr, lane); continue; } r -= I_CO; \
            if (r < I_PW) { const int g = r / 64, rr = r % 64, kb = rr / 8, nb = rr % 8; \
                tr_item(pool_w + (size_t)g * 512 * 512, 512, 64 * kb, 64 * nb, Bcat, KCAT, g * 512 + 64 * nb, 0, nullptr, pool_scale + g * 512, scr, lane); continue; } r -= I_PW; \
            { const int kb = r / 32, nb = r % 32; tr_item(w_down, D, 64 * kb, 64 * nb, WdT, FF, 64 * nb, 0, nullptr, nullptr, scr, lane); } \
        } } while (0)

    if (IN(0)) {
        CONVERT_ITEMS(0, split_conv ? P0_TILES * 128 : NITEMS, gw, NGW, nullptr);
        for (int m = gw; m < MA; m += NGW) {
            const float* src = m < MX ? x + (size_t)m * D : (m < MX + NMETA ? meta + (size_t)(m - MX) * D : nullptr);
            rms_row_to_bf16(src, g_mix, HN + (size_t)m * D, lane);
        }
    }
    SEAM(0);

    if (IN(1)) {
        unsigned* tcnt = (unsigned*)ws + 6144;
        if (!split_conv || bx < G_GEMM) {
            SchedP1 S{(const char*)HN, (const char*)WinT, split_conv ? G_GEMM : G, bx, split_conv ? tcnt : nullptr};
            EpiP1 E{U, Sb, GB, GATES, b_gate};
            pg8::gemm_phase(lds, D, D, S, E);
        } else {
            const int cw = (bx - G_GEMM) * 8 + wave, ncw = (G - G_GEMM) * 8;
            CONVERT_ITEMS(P0_TILES * 128, I_WIN, cw, ncw, tcnt);
            CONVERT_ITEMS(I_WIN, NITEMS, cw, ncw, nullptr);
        }
    }
    SEAM(1);

    if (IN(2)) {
        const int nthr = G * 512;
        for (int idx = vcu * 512 + tid; idx < (MX / 8) * 256; idx += nthr) {
            const int cgp = idx & 255, rb = idx >> 8, b = rb >> 8, t0 = (rb & 255) * 8, col = cgp * 8;
            const int grp = col >> 9;
            if (grp == 0) pool_task<2>(U, ACT2, b, t0, col); else if (grp == 1) pool_task<4>(U, ACT2, b, t0, col); else if (grp == 2) pool_task<8>(U, ACT2, b, t0, col); else pool_task<16>(U, ACT2, b, t0, col);
            conv_task(Sb, GB, conv_w, ACT2, b, t0, col);
        }
    }
    SEAM(2);

    if (IN(3)) {
        SchedP3 S{(const char*)ACT2, (const char*)Bcat, G, bx};
        EpiP3 E{GATES, Z};
        pg8::gemm_phase(lds, 4096, KCAT, S, E);
    }
    SEAM(3);

    if (IN(4)) {
        SchedG S{(const char*)Z, (const char*)WoT, G, bx, 32, 8, D};
        EpiP4 E{x, H1B, SSQ1};
        pg8::gemm_phase(lds, D, D, S, E);
    }
    SEAM(4);

    if (IN(5)) {
        EpiP5 E{SSQ1, ACT};
        { SchedP5a S{(const char*)H1B, (const char*)WguT, G, bx}; pg8::gemm_phase(lds, D, D, S, E); }
        if (G == 256) { SchedP5b S2{(const char*)H1B, (const char*)WguT, bx}; pg8::gemm_phase<true>(lds, D, D, S2, E); }
        if (!split_conv && bx >= 128) CONVERT_ITEMS(IT_MID, NITEMS, (bx - 128) * 8 + wave, (G - 128) * 8, nullptr);
    }
    SEAM(5);

    if (IN(6)) {
        SchedG S{(const char*)ACT, (const char*)WdT, G, bx, 32, 8, FF};
        EpiP6F E{H1B, out, g_final, (unsigned*)(ws + WS_SSQ2), (unsigned*)ws + 4096};
        pg8::gemm_phase(lds, FF, FF, S, E);
    }
#undef IN
#undef SEAM
}

extern "C" void kernel_launch(void* const* d_in, const int* in_sizes, int n_in, void* d_out, int out_size, void* d_ws, size_t ws_size, hipStream_t stream) {
    static int grid = 0;
    if (grid == 0) {
        if (n_in != 14 || out_size != MX * D || ws_size < WS_END) { fprintf(stderr, "kernel_launch: unexpected shapes (n_in %d out %d ws %zu)\n", n_in, out_size, ws_size); grid = -1; return; }
        int dev = 0, cus = 0, per_cu = 0;
        if (hipGetDevice(&dev) != hipSuccess || hipDeviceGetAttribute(&cus, hipDeviceAttributeMultiprocessorCount, dev) != hipSuccess) { grid = -1; return; }
        if (hipFuncSetAttribute((const void*)fwd_megakernel, hipFuncAttributeMaxDynamicSharedMemorySize, LDS_BYTES) != hipSuccess) { fprintf(stderr, "kernel_launch: hipFuncSetAttribute failed\n"); grid = -1; return; }
        if (hipOccupancyMaxActiveBlocksPerMultiprocessor(&per_cu, (const void*)fwd_megakernel, 512, LDS_BYTES) != hipSuccess || per_cu < 1) { fprintf(stderr, "kernel_launch: occupancy query says %d blocks per CU\n", per_cu); per_cu = 1; }
        (void)hipGetLastError();
        if (cus != 256) { fprintf(stderr, "kernel_launch: built for a 256-CU device (got %d)\n", cus); grid = -1; return; }
        grid = cus;
    }
    if (grid < 0) return;
    if (hipMemsetAsync(d_ws, 0, 32768, stream) != hipSuccess) { fprintf(stderr, "kernel_launch: memset failed\n"); return; }
    Args a{};
    for (int i = 0; i < 14; ++i) a.in[i] = (const float*)d_in[i];
    a.out = (float*)d_out; a.ws = (unsigned char*)d_ws;
#if MK_N_LAUNCHES == 1
    a.ph_lo = 0; a.ph_hi = N_PHASES;
    void* args[] = {&a};
    hipError_t e = hipLaunchCooperativeKernel((const void*)fwd_megakernel, dim3(grid), dim3(512), args, LDS_BYTES, stream);
    if (e != hipSuccess) fprintf(stderr, "kernel_launch: cooperative launch failed: %s (grid %d)\n", hipGetErrorString(e), grid);
#else
    for (int p = 0; p < N_PHASES; ++p) { a.ph_lo = p; a.ph_hi = p + 1; hipLaunchKernelGGL(fwd_megakernel, dim3(grid), dim3(512), LDS_BYTES, stream, a); }
#endif
}
```

```cpp
#include <hip/hip_runtime.h>
#include <hip/hip_cooperative_groups.h>
#include <cstdio>
#include <cstdint>
namespace cg = cooperative_groups;

#define LAS __attribute__((address_space(3)))
typedef unsigned short bf16_t;
typedef short bf16x8 __attribute__((ext_vector_type(8)));
typedef float f32x4 __attribute__((ext_vector_type(4)));
typedef unsigned u32x4 __attribute__((ext_vector_type(4)));

#ifndef MK_N_LAUNCHES
#define MK_N_LAUNCHES 1
#endif
constexpr int N_PHASES = 7;

constexpr int D = 2048, SEQ = 2048, NBATCH = 4, NMETA = 16;
constexpr int MX = NBATCH * SEQ;
constexpr int MA = 33 * 256;
constexpr int NIN = 12288, FF = 5632, NGU = 2 * FF, KCAT = 512 + 2048;
constexpr float EPS = 1e-6f;

constexpr size_t MiB = 1u << 20;
constexpr size_t WS_SSQ1 = 1 * MiB, WS_SSQ2 = 2 * MiB;
constexpr size_t WS_WD = 4 * MiB;
constexpr size_t WS_WGU = 26 * MiB;
constexpr size_t WS_WO = 70 * MiB;
constexpr size_t WS_BCAT = 78 * MiB;
constexpr size_t WS_WIN = 88 * MiB;
constexpr size_t WS_HN = 136 * MiB;
constexpr size_t WS_U = 169 * MiB;
constexpr size_t WS_S = 202 * MiB;
constexpr size_t WS_GB = 235 * MiB;
constexpr size_t WS_GATES = 267 * MiB;
constexpr size_t WS_ACT2 = 88 * MiB;
constexpr size_t WS_ZA = 169 * MiB;
constexpr size_t WS_Z = 235 * MiB;
constexpr size_t WS_H1B = 169 * MiB;
constexpr size_t WS_ACT = 202 * MiB;
constexpr size_t WS_END = 331 * MiB;

constexpr int LDS_BYTES = 131072 + 4096;

#define NT_LD(p) __builtin_nontemporal_load(p)
#define NT_ST(v, p) (*(p) = (v))
__device__ __forceinline__ void st16_wt(void* p, const unsigned __attribute__((ext_vector_type(4))) v) { asm volatile("global_store_dwordx4 %0, %1, off sc1\n\ts_nop 1" :: "v"(p), "v"(v) : "memory"); }
typedef __bf16 bf16x2_t __attribute__((ext_vector_type(2)));
typedef float f32x2_t __attribute__((ext_vector_type(2)));
__device__ __forceinline__ unsigned cvt_pk_bf16(float lo, float hi) { const f32x2_t v = {lo, hi}; return __builtin_bit_cast(unsigned, __builtin_convertvector(v, bf16x2_t)); }
__device__ __forceinline__ float bf_lo(unsigned u) { return __uint_as_float(u << 16); }
__device__ __forceinline__ float bf_hi(unsigned u) { return __uint_as_float(u & 0xffff0000u); }
__device__ __forceinline__ void unpack8(const u32x4 w, float (&f)[8]) { f[0] = bf_lo(w.x); f[1] = bf_hi(w.x); f[2] = bf_lo(w.y); f[3] = bf_hi(w.y); f[4] = bf_lo(w.z); f[5] = bf_hi(w.z); f[6] = bf_lo(w.w); f[7] = bf_hi(w.w); }
__device__ __forceinline__ u32x4 pack8(const f32x4 a, const f32x4 b) { u32x4 w; w.x = cvt_pk_bf16(a[0], a[1]); w.y = cvt_pk_bf16(a[2], a[3]); w.z = cvt_pk_bf16(b[0], b[1]); w.w = cvt_pk_bf16(b[2], b[3]); return w; }
__device__ __forceinline__ float sigmoidf_fast(float x) { return __builtin_amdgcn_rcpf(1.0f + __builtin_amdgcn_exp2f(-1.44269504089f * x)); }
__device__ __forceinline__ float wave_sum(float v) {
#pragma unroll
    for (int o = 1; o < 64; o <<= 1) v += __shfl_xor(v, o);
    return v;
}

namespace pg8 {
constexpr int BM = 256, BK = 64, HALF = 128, HTB = HALF * BK * 2, STAGE_BYTES = 8 * HTB;
__device__ __forceinline__ int lds_byte(int r, int c) { const int st = (r >> 4) * 2 + (c >> 5), rr = r & 15, cc = c & 31, ob = rr * 64 + cc * 2; return st * 1024 + (ob ^ (((ob >> 9) & 1) << 5)); }
__device__ __forceinline__ void stage_rc(int b, int& R, int& C) { const int st = b / 1024, sb = b % 1024, swz = sb ^ (((sb >> 9) & 1) << 5); R = (st >> 1) * 16 + swz / 64; C = (st & 1) * 32 + (swz % 64) / 2; }
__device__ __forceinline__ int perm32(int rho) { const int n = rho >> 4, i = rho & 15; return 8 * (i >> 2) + 4 * n + (i & 3); }

struct Unit { const char* A; const char* B; int nt, kind, pm, pn; };

__device__ __forceinline__ void tile_of(int L, int nM, int nN, int& pm, int& pn) {
    const int nwg = nM * nN; int wgid = L;
    { const int q = nwg / 8, r = nwg % 8, xcd = wgid % 8, off = wgid / 8; wgid = (xcd < r ? xcd * (q + 1) : r * (q + 1) + (xcd - r) * q) + off; }
    constexpr int WGM = 4;
    const int nig = WGM * nN, gid = wgid / nig, fm = gid * WGM, gsz = (nM - fm) < WGM ? (nM - fm) : WGM;
    pm = fm + ((wgid % nig) % gsz); pn = (wgid % nig) / gsz;
}

template <bool HALF_M = false, class Sched, class Epi>
__device__ __forceinline__ void gemm_phase(LAS unsigned char* lds, const int ldA, const int ldB, const Sched& S, const Epi& E) {
    const int tid = threadIdx.x, wid = __builtin_amdgcn_readfirstlane(tid >> 6), lane = tid & 63, wr = wid >> 2, wc = wid & 3, fr = lane & 15, fq = lane >> 4;
    unsigned voffA[2], voffB[2];
#pragma unroll
    for (int i = 0; i < 2; ++i) { int R, C; stage_rc(tid * 16 + i * 8192, R, C); const int Rb = (R & ~31) + perm32(R & 31);
        voffA[i] = (unsigned)(R * ldA + C) * 2u; voffB[i] = (unsigned)(Rb * ldB + C) * 2u; }
    const size_t kstep = (size_t)(BK * 2);
    const size_t hstepA = (size_t)HALF * ldA * 2, hstepB = (size_t)HALF * ldB * 2;
    const unsigned ldsw = (unsigned)wid * 1024u;
    const int aoff = lds_byte(wr * 64 + fr, fq * 8), boff = lds_byte(wc * 32 + fr, fq * 8);
#define PG8_SA(b, h) (((b) * 2 + (h)) * HTB)
#define PG8_SB(b, h) ((4 + (b) * 2 + (h)) * HTB)
#define PG8_STAGE(bufoff, gbase, voff) do { _Pragma("unroll") for (int _i = 0; _i < 2; ++_i) \
        __builtin_amdgcn_global_load_lds((const unsigned*)((const char*)(gbase) + (voff)[_i]), (LAS unsigned*)(lds + (bufoff) + ldsw + _i * 8192), 16, 0, 0); } while (0)
#define PG8_LDA(dst, b, h) do { _Pragma("unroll") for (int m = 0; m < 4; ++m) _Pragma("unroll") for (int k = 0; k < 2; ++k) dst[m][k] = *(const LAS bf16x8*)(lds + PG8_SA(b, h) + aoff + m * 2048 + k * 1024); } while (0)
#define PG8_LDB(dst, b, h) do { _Pragma("unroll") for (int n = 0; n < 2; ++n) _Pragma("unroll") for (int k = 0; k < 2; ++k) dst[n][k] = *(const LAS bf16x8*)(lds + PG8_SB(b, h) + boff + n * 2048 + k * 1024); } while (0)
#define PG8_MMA(ai, bj, At, Bt) do { __builtin_amdgcn_s_setprio(1); _Pragma("unroll") for (int m = 0; m < 4; ++m) _Pragma("unroll") for (int n = 0; n < 2; ++n) _Pragma("unroll") for (int k = 0; k < 2; ++k) \
        acc[ai][bj][m][n] = __builtin_amdgcn_mfma_f32_16x16x32_bf16(Bt[n][k], At[m][k], acc[ai][bj][m][n], 0, 0, 0); __builtin_amdgcn_s_setprio(0); } while (0)
#define PG8_WAIT_V(n) asm volatile("s_waitcnt vmcnt(" #n ")" ::: "memory")
#define PG8_WAIT_L(n) asm volatile("s_waitcnt lgkmcnt(" #n ")" ::: "memory")
#define PG8_BAR __builtin_amdgcn_s_barrier()
#define PG8_SCHED __builtin_amdgcn_sched_barrier(0)
    Unit cur, nxt; int ui = 0;
    if (!S.next(0, cur)) return;
    S.ready(cur);
    f32x4 acc[2][2][4][2];
#pragma unroll
    for (int a = 0; a < 2; ++a)
#pragma unroll
        for (int b = 0; b < 2; ++b)
#pragma unroll
            for (int m = 0; m < 4; ++m)
#pragma unroll
                for (int n = 0; n < 2; ++n) acc[a][b][m][n] = (f32x4){0.f, 0.f, 0.f, 0.f};
    bf16x8 At[4][2], B0[2][2], B1[2][2];
    const char* cA = cur.A; const char* cB = cur.B;
    if constexpr (HALF_M) {
        PG8_STAGE(PG8_SB(0, 0), cB, voffB); PG8_STAGE(PG8_SB(0, 1), cB + hstepB, voffB); PG8_STAGE(PG8_SA(0, 0), cA, voffA);
        if (wr == 1) PG8_BAR;
        PG8_WAIT_V(0); PG8_BAR;
        PG8_STAGE(PG8_SB(1, 0), cB + kstep, voffB); PG8_STAGE(PG8_SA(1, 0), cA + kstep, voffA); PG8_STAGE(PG8_SB(1, 1), cB + hstepB + kstep, voffB);
        PG8_BAR;
    } else {
    PG8_STAGE(PG8_SB(0, 0), cB, voffB); PG8_STAGE(PG8_SB(0, 1), cB + hstepB, voffB); PG8_STAGE(PG8_SA(0, 0), cA, voffA); PG8_STAGE(PG8_SA(0, 1), cA + hstepA, voffA);
    if (wr == 1) PG8_BAR;
    PG8_WAIT_V(2); PG8_BAR;
    PG8_STAGE(PG8_SB(1, 0), cB + kstep, voffB); PG8_STAGE(PG8_SA(1, 0), cA + kstep, voffA); PG8_STAGE(PG8_SB(1, 1), cB + hstepB + kstep, voffB);
    PG8_WAIT_V(6); PG8_BAR;
    }
    for (;;) {
        const bool has_next = S.next(ui + 1, nxt);
        if (has_next) S.ready(nxt);
        const char* nA = has_next ? nxt.A : cA; const char* nB = has_next ? nxt.B : cB;
        const int nt = cur.nt;
        for (int t = 0; t < nt; t += 2) {
            const bool last = (t == nt - 2);
            const char* a1 = cA + (size_t)(t + 1) * kstep;
            const char* a2 = last ? nA : cA + (size_t)(t + 2) * kstep; const char* b2 = last ? nB : cB + (size_t)(t + 2) * kstep;
            const char* a3 = a2 + kstep; const char* b3 = b2 + kstep;
            if constexpr (HALF_M) {
            (void)a1;
            PG8_LDB(B0, 0, 0); PG8_LDB(B1, 0, 1); PG8_SCHED; PG8_LDA(At, 0, 0);
            PG8_WAIT_L(0); PG8_BAR; PG8_MMA(0, 0, At, B0); PG8_MMA(0, 1, At, B1); PG8_BAR; PG8_SCHED;
            PG8_STAGE(PG8_SB(0, 0), b2, voffB); PG8_STAGE(PG8_SB(0, 1), b2 + hstepB, voffB); PG8_STAGE(PG8_SA(0, 0), a2, voffA);
            PG8_WAIT_V(6); PG8_BAR; PG8_BAR; PG8_SCHED;
            PG8_LDB(B0, 1, 0); PG8_LDB(B1, 1, 1); PG8_SCHED; PG8_LDA(At, 1, 0);
            PG8_WAIT_L(0); PG8_BAR; PG8_MMA(0, 0, At, B0); PG8_MMA(0, 1, At, B1); PG8_BAR; PG8_SCHED;
            PG8_STAGE(PG8_SB(1, 0), b3, voffB); PG8_STAGE(PG8_SB(1, 1), b3 + hstepB, voffB); PG8_STAGE(PG8_SA(1, 0), a3, voffA);
            PG8_WAIT_V(6); PG8_BAR; PG8_BAR; PG8_SCHED;
            } else {
            PG8_LDB(B0, 0, 0); PG8_LDB(B1, 0, 1); PG8_SCHED; PG8_LDA(At, 0, 0); PG8_STAGE(PG8_SA(1, 1), a1 + hstepA, voffA);
            PG8_WAIT_V(8); PG8_WAIT_L(0); PG8_BAR; PG8_MMA(0, 0, At, B0); PG8_MMA(0, 1, At, B1); PG8_BAR; PG8_SCHED;
            PG8_LDA(At, 0, 1); PG8_STAGE(PG8_SB(0, 0), b2, voffB); PG8_STAGE(PG8_SB(0, 1), b2 + hstepB, voffB); PG8_STAGE(PG8_SA(0, 0), a2, voffA);
            PG8_WAIT_V(8); PG8_WAIT_L(0); PG8_BAR; PG8_MMA(1, 0, At, B0); PG8_MMA(1, 1, At, B1); PG8_BAR; PG8_SCHED;
            PG8_LDB(B0, 1, 0); PG8_LDB(B1, 1, 1); PG8_SCHED; PG8_LDA(At, 1, 0); PG8_STAGE(PG8_SA(0, 1), a2 + hstepA, voffA);
            PG8_WAIT_V(8); PG8_WAIT_L(0); PG8_BAR; PG8_MMA(0, 0, At, B0); PG8_MMA(0, 1, At, B1); PG8_BAR; PG8_SCHED;
            PG8_LDA(At, 1, 1); PG8_STAGE(PG8_SB(1, 0), b3, voffB); PG8_STAGE(PG8_SB(1, 1), b3 + hstepB, voffB); PG8_STAGE(PG8_SA(1, 0), a3, voffA);
            PG8_WAIT_V(8); PG8_WAIT_L(0); PG8_BAR; PG8_MMA(1, 0, At, B0); PG8_MMA(1, 1, At, B1); PG8_BAR; PG8_SCHED;
            }
        }
        if (wr == 0) PG8_BAR;
        if constexpr (!Epi::AFTER_DRAIN) E(acc, cur, wr, wc, fr, fq);
        if (!has_next) break;
        if (!Epi::keep_acc(cur)) {
#pragma unroll
        for (int a = 0; a < 2; ++a)
#pragma unroll
            for (int b = 0; b < 2; ++b)
#pragma unroll
                for (int m = 0; m < 4; ++m)
#pragma unroll
                    for (int n = 0; n < 2; ++n) acc[a][b][m][n] = (f32x4){0.f, 0.f, 0.f, 0.f};
        }
        cur = nxt; cA = nA; cB = nB; ++ui;
        if (wr == 1) PG8_BAR;
    }
    PG8_WAIT_V(0);
    PG8_BAR;
    if constexpr (Epi::AFTER_DRAIN) E.fused(acc, cur, wr, wc, fr, fq, lds, wid, lane);
#undef PG8_SA
#undef PG8_SB
#undef PG8_STAGE
#undef PG8_LDA
#undef PG8_LDB
#undef PG8_MMA
#undef PG8_WAIT_V
#undef PG8_WAIT_L
#undef PG8_BAR
#undef PG8_SCHED
}
}
using pg8::Unit;
typedef f32x4 Acc[2][2][4][2];

struct SchedP1 { const char* A; const char* B; int G, c; unsigned* cnt;
    __device__ __forceinline__ void ready(const Unit& u) const {
        if (cnt == nullptr || u.pn < 14) return;
        if (threadIdx.x < 64) { unsigned sp = 0;
            while ((unsigned)__builtin_amdgcn_readfirstlane(__hip_atomic_load(cnt + 32 * u.pn, __ATOMIC_RELAXED, __HIP_MEMORY_SCOPE_AGENT)) < 128u) { __builtin_amdgcn_s_sleep(2); if (++sp > (1u << 22)) break; }
            __builtin_amdgcn_fence(__ATOMIC_ACQUIRE, "agent"); asm volatile("s_waitcnt vmcnt(0)" ::: "memory"); }
        asm volatile("" ::: "memory"); __builtin_amdgcn_s_barrier(); asm volatile("" ::: "memory");
    }
    __device__ __forceinline__ bool next(int i, Unit& u) const {
        const int L = i * G + c; if (L >= 1536 + 24) return false;
        int pm, pn; if (L < 1536) pg8::tile_of(L, 32, 48, pm, pn); else { pm = 32; pn = L - 1536; }
        u.A = A + (size_t)pm * 256 * D * 2; u.B = B + (size_t)pn * 256 * D * 2; u.nt = D / 64; u.kind = 0; u.pm = pm; u.pn = pn; return true; } };
struct SchedP3 { const char* A; const char* B; int G, c;
    __device__ __forceinline__ void ready(const Unit&) const {}
    __device__ __forceinline__ bool next(int i, Unit& u) const {
        const int L = (i >> 1) * G + c, part = i & 1; if (L >= 256) return false;
        int pm, pn; pg8::tile_of(L, 32, 8, pm, pn);
        u.A = A + ((size_t)pm * 256 * 4096 + (part ? 2048 : (pn >> 1) * 512)) * 2; u.B = B + ((size_t)pn * 256 * KCAT + (part ? 512 : 0)) * 2;
        u.nt = part ? 32 : 8; u.kind = part; u.pm = pm; u.pn = pn; return true; } };
struct SchedG { const char* A; const char* B; int G, c, nM, nN, K;
    __device__ __forceinline__ void ready(const Unit&) const {}
    __device__ __forceinline__ bool next(int i, Unit& u) const {
        const int L = i * G + c; if (L >= nM * nN) return false;
        int pm, pn; pg8::tile_of(L, nM, nN, pm, pn);
        u.A = A + (size_t)pm * 256 * K * 2; u.B = B + (size_t)pn * 256 * K * 2; u.nt = K / 64; u.kind = 0; u.pm = pm; u.pn = pn; return true; } };

struct SchedP5a { const char* A; const char* B; int G, c;
    __device__ __forceinline__ void ready(const Unit&) const {}
    __device__ __forceinline__ bool next(int i, Unit& u) const {
        const int L = i * G + c; if (L >= (G == 256 ? 1280 : 32 * 44)) return false;
        int pm, pn; pg8::tile_of(L, 32, 44, pm, pn);
        u.A = A + (size_t)pm * 256 * D * 2; u.B = B + (size_t)pn * 256 * D * 2; u.nt = D / 64; u.kind = 0; u.pm = pm; u.pn = pn; return true; } };
struct SchedP5b { const char* A; const char* B; int c;
    __device__ __forceinline__ void ready(const Unit&) const {}
    __device__ __forceinline__ bool next(int i, Unit& u) const {
        if (i > 0) return false;
        const int h = c >> 7; int pm, pn; pg8::tile_of(1280 + (c & 127), 32, 44, pm, pn);
        u.A = A + ((size_t)pm * 256 + h * 128) * D * 2; u.B = B + (size_t)pn * 256 * D * 2; u.nt = D / 64; u.kind = 4 | h; u.pm = pm; u.pn = pn; return true; } };

struct EpiP1 { static constexpr bool AFTER_DRAIN = false; static __device__ __forceinline__ bool keep_acc(const Unit&) { return false; } bf16_t* U; bf16_t* Sb; bf16_t* GB; bf16_t* GATES; const float* b_gate;
    __device__ __forceinline__ void operator()(const Acc& acc, const Unit& u, int wr, int wc, int fr, int fq) const {
        const int row0 = u.pm * 256 + wr * 64 + fr, cl = wc * 32 + 8 * fq, pn = u.pn;
        if (pn < 8 || (pn >= 24 && pn < 32)) {
            bf16_t* base = (pn < 8) ? U + pn * 256 : GB + (pn - 24) * 256;
#pragma unroll
            for (int ai = 0; ai < 2; ++ai)
#pragma unroll
                for (int m = 0; m < 4; ++m) { bf16_t* rowp = base + (size_t)(row0 + ai * 128 + m * 16) * D + cl;
#pragma unroll
                    for (int bj = 0; bj < 2; ++bj) NT_ST(pack8(acc[ai][bj][m][0], acc[ai][bj][m][1]), (u32x4*)(rowp + bj * 128)); }
        } else if (pn < 24) {
            bf16_t* base = Sb + (pn - 8) * 128 + cl;
#pragma unroll
            for (int ai = 0; ai < 2; ++ai)
#pragma unroll
                for (int m = 0; m < 4; ++m)
                    NT_ST(pack8(acc[ai][0][m][0] * acc[ai][1][m][0], acc[ai][0][m][1] * acc[ai][1][m][1]), (u32x4*)(base + (size_t)(row0 + ai * 128 + m * 16) * D));
        } else {
            const int ch0 = (pn - 32) * 128 + cl;
            f32x4 ba[2], bb[2];
#pragma unroll
            for (int n = 0; n < 2; ++n) { ba[n] = *(const f32x4*)(b_gate + ch0 + 4 * n); bb[n] = *(const f32x4*)(b_gate + 2048 + ch0 + 4 * n); }
#pragma unroll
            for (int ai = 0; ai < 2; ++ai)
#pragma unroll
                for (int m = 0; m < 4; ++m) { bf16_t* rowp = GATES + (size_t)(row0 + ai * 128 + m * 16) * 4096 + ch0;
                    f32x4 ga0 = acc[ai][0][m][0] + ba[0], ga1 = acc[ai][0][m][1] + ba[1], gb0 = acc[ai][1][m][0] + bb[0], gb1 = acc[ai][1][m][1] + bb[1];
#pragma unroll
                    for (int j = 0; j < 4; ++j) { ga0[j] = sigmoidf_fast(ga0[j]); ga1[j] = sigmoidf_fast(ga1[j]); gb0[j] = sigmoidf_fast(gb0[j]); gb1[j] = sigmoidf_fast(gb1[j]); }
                    const u32x4 gbp = pack8(gb0, gb1); float gbr[8]; unpack8(gbp, gbr);
#pragma unroll
                    for (int j = 0; j < 4; ++j) { ga0[j] *= __builtin_amdgcn_rcpf(fmaxf(gbr[j], 1e-30f)); ga1[j] *= __builtin_amdgcn_rcpf(fmaxf(gbr[4 + j], 1e-30f)); }
                    NT_ST(pack8(ga0, ga1), (u32x4*)rowp); NT_ST(gbp, (u32x4*)(rowp + 2048)); }
        }
    }
};
struct EpiP3 { static constexpr bool AFTER_DRAIN = false; static __device__ __forceinline__ bool keep_acc(const Unit& u) { return u.kind == 0; }
    const bf16_t* GATES; bf16_t* Z;
    __device__ __forceinline__ void operator()(Acc& acc, const Unit& u, int wr, int wc, int fr, int fq) const {
        const int row0 = u.pm * 256 + wr * 64 + fr, col0 = u.pn * 256 + wc * 32 + 8 * fq;
        const bool k0 = (u.kind == 0);
        const int goff = k0 ? 0 : 2048;
        u32x4 gbuf[2][2];
#define P3_LOAD(buf, g) do { const size_t row_ = (size_t)(row0 + ((g) >> 2) * 128 + ((g) & 3) * 16); const bf16_t* gp_ = GATES + row_ * 4096 + goff + col0; \
            gbuf[buf][0] = NT_LD((const u32x4*)(gp_)); gbuf[buf][1] = NT_LD((const u32x4*)(gp_ + 128)); } while (0)
        P3_LOAD(0, 0);
#pragma unroll
        for (int g = 0; g < 8; ++g) { const int ai = g >> 2, m = g & 3; const size_t row = (size_t)(row0 + ai * 128 + m * 16);
            if (g + 1 < 8) P3_LOAD((g + 1) & 1, g + 1);
#pragma unroll
            for (int bj = 0; bj < 2; ++bj) { const int col = col0 + bj * 128;
                float f[8]; unpack8(gbuf[g & 1][bj], f);
                if (k0) {
#pragma unroll
                    for (int j = 0; j < 4; ++j) { acc[ai][bj][m][0][j] *= f[j]; acc[ai][bj][m][1][j] *= f[4 + j]; }
                } else {
                    f32x4 v0 = acc[ai][bj][m][0], v1 = acc[ai][bj][m][1];
#pragma unroll
                    for (int j = 0; j < 4; ++j) { v0[j] *= fmaxf(f[j], 1e-30f); v1[j] *= fmaxf(f[4 + j], 1e-30f); }
                    *(u32x4*)(Z + row * D + col) = pack8(v0, v1); } }
            asm volatile("" ::: "memory"); }
#undef P3_LOAD
    }
};
struct EpiP4 { static constexpr bool AFTER_DRAIN = false; static __device__ __forceinline__ bool keep_acc(const Unit&) { return false; } const float* base; bf16_t* hb; float* ssq;
    __device__ __forceinline__ void operator()(const Acc& acc, const Unit& u, int wr, int wc, int fr, int fq) const {
        const int row0 = u.pm * 256 + wr * 64 + fr, col0 = u.pn * 256 + wc * 32 + 8 * fq;
        f32x4 xbuf[2][4];
#define P4_LOAD(buf, g) do { const float* xp_ = base + (size_t)(row0 + ((g) >> 2) * 128 + ((g) & 3) * 16) * D + col0; \
            xbuf[buf][0] = NT_LD((const f32x4*)(xp_)); xbuf[buf][1] = NT_LD((const f32x4*)(xp_ + 4)); xbuf[buf][2] = NT_LD((const f32x4*)(xp_ + 128)); xbuf[buf][3] = NT_LD((const f32x4*)(xp_ + 132)); } while (0)
        P4_LOAD(0, 0);
#pragma unroll
        for (int g = 0; g < 8; ++g) { const int ai = g >> 2, m = g & 3; const size_t row = (size_t)(row0 + ai * 128 + m * 16); float s = 0.f;
            if (g + 1 < 8) P4_LOAD((g + 1) & 1, g + 1);
#pragma unroll
            for (int bj = 0; bj < 2; ++bj) { const size_t off = row * D + col0 + bj * 128;
                const f32x4 v0 = xbuf[g & 1][2 * bj] + acc[ai][bj][m][0], v1 = xbuf[g & 1][2 * bj + 1] + acc[ai][bj][m][1];
                *(u32x4*)(hb + off) = pack8(v0, v1);
                s += (v0[0] * v0[0] + v0[1] * v0[1]) + (v0[2] * v0[2] + v0[3] * v0[3]) + (v1[0] * v1[0] + v1[1] * v1[1]) + (v1[2] * v1[2] + v1[3] * v1[3]); }
            s += __shfl_xor(s, 16); s += __shfl_xor(s, 32);
            if (fq == 0) ssq[row * 32 + u.pn * 4 + wc] = s;
            asm volatile("" ::: "memory"); }
#undef P4_LOAD
    }
};
struct EpiP6F { static constexpr bool AFTER_DRAIN = true; static __device__ __forceinline__ bool keep_acc(const Unit&) { return false; } const bf16_t* h1b; float* out; const float* gfin; unsigned* xbuf; unsigned* cnt;
    __device__ __forceinline__ void operator()(const Acc&, const Unit&, int, int, int, int) const {}
    __device__ __forceinline__ void fused(Acc& acc, const Unit& u, int wr, int wc, int fr, int fq, LAS unsigned char* lds, int wid, int lane) const {
        LAS float* P = (LAS float*)lds;
        LAS float* S = (LAS float*)(lds + 4096);
        const int row0 = u.pm * 256 + wr * 64 + fr, col0 = u.pn * 256 + wc * 32 + 8 * fq;
#pragma unroll
        for (int ai = 0; ai < 2; ++ai)
#pragma unroll
            for (int m = 0; m < 4; ++m) { const size_t row = (size_t)(row0 + ai * 128 + m * 16); float s = 0.f;
#pragma unroll
                for (int bj = 0; bj < 2; ++bj) { float h[8]; unpack8(NT_LD((const u32x4*)(h1b + row * D + col0 + bj * 128)), h);
#pragma unroll
                    for (int j = 0; j < 4; ++j) { acc[ai][bj][m][0][j] += h[j]; acc[ai][bj][m][1][j] += h[4 + j]; }
                    const f32x4 v0 = acc[ai][bj][m][0], v1 = acc[ai][bj][m][1];
                    s += (v0[0] * v0[0] + v0[1] * v0[1]) + (v0[2] * v0[2] + v0[3] * v0[3]) + (v1[0] * v1[0] + v1[1] * v1[1]) + (v1[2] * v1[2] + v1[3] * v1[3]); }
                s += __shfl_xor(s, 16); s += __shfl_xor(s, 32);
                if (fq == 0) P[(ai * 128 + wr * 64 + m * 16 + fr) * 4 + wc] = s; }
        asm volatile("s_waitcnt lgkmcnt(0)" ::: "memory"); __builtin_amdgcn_s_barrier(); asm volatile("" ::: "memory");
        const int rl = wid * 32 + (lane & 31);
        if (lane < 32) { const float t = (P[rl * 4 + 0] + P[rl * 4 + 1]) + (P[rl * 4 + 2] + P[rl * 4 + 3]);
            __hip_atomic_store(xbuf + ((size_t)(u.pm * 256 + rl) * 8 + u.pn), __float_as_uint(t), __ATOMIC_RELAXED, __HIP_MEMORY_SCOPE_AGENT); }
        asm volatile("s_waitcnt vmcnt(0)" ::: "memory");
        if (lane == 0) __hip_atomic_fetch_add(cnt + 64 * u.pm, 1u, __ATOMIC_RELAXED, __HIP_MEMORY_SCOPE_AGENT);
        if (wid == 0) { unsigned sp = 0;
            while ((unsigned)__builtin_amdgcn_readfirstlane(__hip_atomic_load(cnt + 64 * u.pm, __ATOMIC_RELAXED, __HIP_MEMORY_SCOPE_AGENT)) < 64u) { __builtin_amdgcn_s_sleep(2); if (++sp > (1u << 22)) break; }
            __builtin_amdgcn_fence(__ATOMIC_ACQUIRE, "agent"); }
        asm volatile("s_waitcnt vmcnt(0) lgkmcnt(0)" ::: "memory"); __builtin_amdgcn_s_barrier(); asm volatile("" ::: "memory");
        if (lane < 32) { const unsigned* slot = xbuf + (size_t)(u.pm * 256 + rl) * 8; float t = 0.f;
#pragma unroll
            for (int k = 0; k < 8; ++k) t += __uint_as_float(__hip_atomic_load(slot + k, __ATOMIC_RELAXED, __HIP_MEMORY_SCOPE_AGENT));
            S[rl] = 1.0f / sqrtf(t * (1.0f / D) + EPS); }
        asm volatile("s_waitcnt lgkmcnt(0)" ::: "memory"); __builtin_amdgcn_s_barrier(); asm volatile("" ::: "memory");
        f32x4 gv[2][2];
#pragma unroll
        for (int bj = 0; bj < 2; ++bj)
#pragma unroll
            for (int n = 0; n < 2; ++n) gv[bj][n] = *(const f32x4*)(gfin + col0 + bj * 128 + 4 * n);
#pragma unroll
        for (int ai = 0; ai < 2; ++ai)
#pragma unroll
            for (int m = 0; m < 4; ++m) { const int rloc = ai * 128 + wr * 64 + m * 16 + fr; const float rstd = S[rloc]; float* rowp = out + (size_t)(u.pm * 256 + rloc) * D + col0;
#pragma unroll
                for (int bj = 0; bj < 2; ++bj) { NT_ST(acc[ai][bj][m][0] * rstd * gv[bj][0], (f32x4*)(rowp + bj * 128)); NT_ST(acc[ai][bj][m][1] * rstd * gv[bj][1], (f32x4*)(rowp + bj * 128 + 4)); } }
    }
};
struct EpiP5 { static constexpr bool AFTER_DRAIN = false; static __device__ __forceinline__ bool keep_acc(const Unit&) { return false; } const float* ssq; bf16_t* ACT;
    __device__ __forceinline__ void operator()(const Acc& acc, const Unit& u, int wr, int wc, int fr, int fq) const {
        const bool half = (u.kind & 4) != 0;
        const int row0 = u.pm * 256 + (half ? (u.kind & 1) * 128 : 0) + wr * 64 + fr, col0 = u.pn * 128 + wc * 32 + 8 * fq;
#pragma unroll
        for (int ai = 0; ai < 2; ++ai) { if (ai == 1 && half) break;
#pragma unroll
            for (int m = 0; m < 4; ++m) { const size_t row = (size_t)(row0 + ai * 128 + m * 16);
                const f32x4 p0 = *(const f32x4*)(ssq + row * 32 + 8 * fq), p1 = *(const f32x4*)(ssq + row * 32 + 8 * fq + 4);
                float s = ((p0[0] + p0[1]) + (p0[2] + p0[3])) + ((p1[0] + p1[1]) + (p1[2] + p1[3]));
                s += __shfl_xor(s, 16); s += __shfl_xor(s, 32);
                const float rstd = __builtin_amdgcn_rsqf(s * (1.0f / D) + EPS);
                f32x4 o[2];
#pragma unroll
                for (int n = 0; n < 2; ++n)
#pragma unroll
                    for (int j = 0; j < 4; ++j) { const float g = acc[ai][0][m][n][j] * rstd, up = acc[ai][1][m][n][j] * rstd; o[n][j] = g * sigmoidf_fast(g) * up; }
                NT_ST(pack8(o[0], o[1]), (u32x4*)(ACT + row * FF + col0)); } }
    }
};

__device__ __forceinline__ void tr_item(const float* __restrict__ W, int N, int k0, int n0, bf16_t* WT, int ldT, int drow0, int kd0, const float* rs, const float* cs, LAS float* scr, int lane, bool wt = false) {
    const int r = lane >> 4, q = lane & 15;
    f32x4 v[16];
#pragma unroll
    for (int j = 0; j < 16; ++j) v[j] = __builtin_nontemporal_load((const f32x4*)(W + (size_t)(k0 + 4 * j + r) * N + n0 + 4 * q));
#pragma unroll
    for (int j = 0; j < 16; ++j) { LAS float* d = scr + (4 * j + r) * 65 + 4 * q; d[0] = v[j][0]; d[1] = v[j][1]; d[2] = v[j][2]; d[3] = v[j][3]; }
    asm volatile("s_waitcnt lgkmcnt(0)" ::: "memory");
    const int c = lane & 7;
    f32x4 r0 = {1.f, 1.f, 1.f, 1.f}, r1 = {1.f, 1.f, 1.f, 1.f};
    if (rs) { r0 = *(const f32x4*)(rs + k0 + 8 * c); r1 = *(const f32x4*)(rs + k0 + 8 * c + 4); }
#pragma unroll
    for (int j = 0; j < 8; ++j) { const int n = (lane >> 3) + 8 * j; const LAS float* sp = scr + (8 * c) * 65 + n; const float sc = cs ? cs[n0 + n] : 1.0f;
        u32x4 o; o.x = cvt_pk_bf16(sp[0 * 65] * r0[0] * sc, sp[1 * 65] * r0[1] * sc); o.y = cvt_pk_bf16(sp[2 * 65] * r0[2] * sc, sp[3 * 65] * r0[3] * sc);
        o.z = cvt_pk_bf16(sp[4 * 65] * r1[0] * sc, sp[5 * 65] * r1[1] * sc); o.w = cvt_pk_bf16(sp[6 * 65] * r1[2] * sc, sp[7 * 65] * r1[3] * sc);
        if (wt) st16_wt(WT + (size_t)(drow0 + n) * ldT + kd0 + k0 + 8 * c, o); else *(u32x4*)(WT + (size_t)(drow0 + n) * ldT + kd0 + k0 + 8 * c) = o; }
    asm volatile("s_waitcnt lgkmcnt(0)" ::: "memory");
}
__device__ __forceinline__ void rms_row_to_bf16(const float* src, const float* g, bf16_t* dst, int lane) {
    u32x4* o = (u32x4*)dst;
    if (!src) {
#pragma unroll
        for (int j = 0; j < 4; ++j) o[lane + 64 * j] = (u32x4){0u, 0u, 0u, 0u};
        return; }
    const f32x4* xr = (const f32x4*)src; const f32x4* gr = (const f32x4*)g;
    f32x4 v[4][2]; float s = 0.f;
#pragma unroll
    for (int j = 0; j < 4; ++j)
#pragma unroll
        for (int h = 0; h < 2; ++h) { v[j][h] = NT_LD(xr + 2 * (lane + 64 * j) + h); s += (v[j][h][0] * v[j][h][0] + v[j][h][1] * v[j][h][1]) + (v[j][h][2] * v[j][h][2] + v[j][h][3] * v[j][h][3]); }
    const float rstd = 1.0f / sqrtf(wave_sum(s) * (1.0f / D) + EPS);
#pragma unroll
    for (int j = 0; j < 4; ++j) { const f32x4 g0 = gr[2 * (lane + 64 * j)], g1 = gr[2 * (lane + 64 * j) + 1];
        o[lane + 64 * j] = pack8(v[j][0] * rstd * g0, v[j][1] * rstd * g1); }
}


__device__ __forceinline__ int seq_row(int b, int l) { return l >= NMETA ? b * SEQ + (l - NMETA) : MX + l; }
template <int W> __device__ __forceinline__ void pool_task(const bf16_t* U, bf16_t* ACT2, int b, int t0, int col) {
    constexpr int NR = W + 7;
    u32x4 raw[NR];
#pragma unroll
    for (int k = 0; k < NR; ++k) raw[k] = *(const u32x4*)(U + (size_t)seq_row(b, t0 + NMETA - (W - 1) + k) * D + col);
    float sum[8];
#pragma unroll
    for (int j = 0; j < 8; ++j) sum[j] = 0.f;
#pragma unroll
    for (int k = 0; k < W - 1; ++k) { float f[8]; unpack8(raw[k], f);
#pragma unroll
        for (int j = 0; j < 8; ++j) sum[j] += f[j]; }
    const float inv = 1.0f / (float)W;
#pragma unroll
    for (int r = 0; r < 8; ++r) { float fn[8], fo[8]; unpack8(raw[W - 1 + r], fn); unpack8(raw[r], fo);
        f32x4 o0, o1;
#pragma unroll
        for (int j = 0; j < 8; ++j) sum[j] += fn[j];
#pragma unroll
        for (int j = 0; j < 4; ++j) { o0[j] = sum[j] * inv - fn[j]; o1[j] = sum[4 + j] * inv - fn[4 + j]; }
#pragma unroll
        for (int j = 0; j < 8; ++j) sum[j] -= fo[j];
        *(u32x4*)(ACT2 + (size_t)(b * SEQ + t0 + r) * 4096 + col) = pack8(o0, o1); }
}
__device__ __forceinline__ void conv_task(const bf16_t* Sb, const bf16_t* GB, const float* conv_w, bf16_t* ACT2, int b, int t0, int col) {
    u32x4 sr[10], gr[8];
#pragma unroll
    for (int k = 0; k < 10; ++k) sr[k] = *(const u32x4*)(Sb + (size_t)seq_row(b, t0 + NMETA - 2 + k) * D + col);
#pragma unroll
    for (int r = 0; r < 8; ++r) gr[r] = *(const u32x4*)(GB + (size_t)(b * SEQ + t0 + r) * D + col);
    float w0[8], w1[8], w2[8];
#pragma unroll
    for (int h = 0; h < 2; ++h) { const f32x4 a = *(const f32x4*)(conv_w + col + 4 * h), bb = *(const f32x4*)(conv_w + D + col + 4 * h), c = *(const f32x4*)(conv_w + 2 * D + col + 4 * h);
#pragma unroll
        for (int j = 0; j < 4; ++j) { w0[4 * h + j] = a[j]; w1[4 * h + j] = bb[j]; w2[4 * h + j] = c[j]; } }
#pragma unroll
    for (int r = 0; r < 8; ++r) { float s0[8], s1[8], s2[8], g[8]; unpack8(sr[r], s0); unpack8(sr[r + 1], s1); unpack8(sr[r + 2], s2); unpack8(gr[r], g);
        f32x4 o0, o1;
#pragma unroll
        for (int j = 0; j < 4; ++j) { o0[j] = g[j] * (w0[j] * s0[j] + w1[j] * s1[j] + w2[j] * s2[j]); o1[j] = g[4 + j] * (w0[4 + j] * s0[4 + j] + w1[4 + j] * s1[4 + j] + w2[4 + j] * s2[4 + j]); }
        *(u32x4*)(ACT2 + (size_t)(b * SEQ + t0 + r) * 4096 + 2048 + col) = pack8(o0, o1); }
}

#define XB_TMO      128
#define XB_XCNT(j)  (256  + 64 * (j))
#define XB_XSUB(j)  (1280 + 64 * (j))
#define XB_XGEN(j)  (2304 + 64 * (j))
#define XB_TOP      3328
#define XB_TOPGEN   3392
#define XCD_BAR_WORDS 3456
#define XB_SPIN_CAP (1u << 18)
__device__ __forceinline__ unsigned xb_ld(unsigned* p)              { return __hip_atomic_load(p, __ATOMIC_RELAXED, __HIP_MEMORY_SCOPE_AGENT); }
__device__ __forceinline__ unsigned xb_add(unsigned* p, unsigned v) { return __hip_atomic_fetch_add(p, v, __ATOMIC_RELAXED, __HIP_MEMORY_SCOPE_AGENT); }
__device__ __forceinline__ unsigned xb_xcc_id() { return (unsigned)__builtin_amdgcn_s_getreg((3 << 11) | 20) & 0xFu; }
#define XB_SPIN(cond, bar) do { unsigned _sp = 0; while (cond) { __builtin_amdgcn_s_sleep(1); \
    if ((++_sp & 255u) == 0u) { if (xb_ld(&(bar)[XB_TMO])) break; if (_sp > XB_SPIN_CAP) { atomicAdd(&(bar)[XB_TMO], 1u); break; } } } } while (0)
struct XcdBarrier { unsigned* bar; unsigned x; volatile LAS unsigned* st; };
__device__ __forceinline__ XcdBarrier xcd_barrier_post(unsigned* bar, volatile LAS unsigned* st) {
    XcdBarrier b; b.bar = bar; b.x = xb_xcc_id(); b.st = st;
    if (threadIdx.x == 0) (void)xb_add(&bar[XB_XCNT(b.x)], 1u);
    return b;
}
__device__ __forceinline__ void xcd_barrier_complete(unsigned* bar, unsigned x, unsigned& nloc, unsigned& nx) {
    const unsigned G = gridDim.x * gridDim.y * gridDim.z;
    unsigned sum, cnt, mine, sp = 0u;
    for (;;) {
        sum = 0u; cnt = 0u; mine = 0u;
#pragma unroll
        for (unsigned j = 0; j < 16; ++j) { const unsigned c = xb_ld(&bar[XB_XCNT(j)]); sum += c; cnt += (c > 0u) ? 1u : 0u; mine = (j == x) ? c : mine; }
        if (sum == G) break;
        __builtin_amdgcn_s_sleep(1);
        if ((++sp & 255u) == 0u) { if (xb_ld(&bar[XB_TMO])) break; if (sp > XB_SPIN_CAP) { atomicAdd(&bar[XB_TMO], 1u); break; } }
    }
    nloc = mine > 0u ? mine : 1u; nx = cnt > 0u ? cnt : 1u;
}
__device__ __forceinline__ void xcd_barrier(const XcdBarrier& b) {
    asm volatile("s_waitcnt vmcnt(0)" ::: "memory");
    __syncthreads();
    if (threadIdx.x == 0) {
        unsigned* bar = b.bar;
        __builtin_amdgcn_s_waitcnt(0);
        unsigned nloc = b.st[0], nx = b.st[1];
        if (nloc == 0u) { xcd_barrier_complete(bar, b.x, nloc, nx); b.st[0] = nloc; b.st[1] = nx; }
        const unsigned old = xb_add(&bar[XB_XSUB(b.x)], 1u);
        const unsigned gen = old / nloc;
        if (old + 1u == (gen + 1u) * nloc) {
            __builtin_amdgcn_fence(__ATOMIC_RELEASE, "agent");
            asm volatile("s_waitcnt vmcnt(0)" ::: "memory");
            const unsigned og = xb_add(&bar[XB_TOP], 1u);
            const unsigned tg = og / nx;
            if (og + 1u == (tg + 1u) * nx) xb_add(&bar[XB_TOPGEN], 1u);
            else XB_SPIN(xb_ld(&bar[XB_TOPGEN]) == tg, bar);
            __builtin_amdgcn_fence(__ATOMIC_ACQUIRE, "agent");
            xb_add(&bar[XB_XGEN(b.x)], 1u);
            asm volatile("s_waitcnt vmcnt(0)" ::: "memory");
        } else {
            XB_SPIN(xb_ld(&bar[XB_XGEN(b.x)]) == gen, bar);
            __builtin_amdgcn_fence(__ATOMIC_ACQUIRE, "agent");
            asm volatile("s_waitcnt vmcnt(0)" ::: "memory");
        }
    }
    __syncthreads();
}

struct Args { const float* in[14]; float* out; unsigned char* ws; int ph_lo, ph_hi; };

__global__ void __launch_bounds__(512, 2) fwd_megakernel(Args a) {
    extern __shared__ __attribute__((aligned(16))) unsigned char lds_raw[];
    LAS unsigned char* lds = (LAS unsigned char*)lds_raw;
    cg::grid_group grid = cg::this_grid();
    const int tid = threadIdx.x, lane = tid & 63, wave = __builtin_amdgcn_readfirstlane(tid >> 6);
    const int G = gridDim.x, bx = blockIdx.x;
    const int vcu = (G % 8 == 0) ? (bx % 8) * (G / 8) + bx / 8 : bx;
    const int gw = vcu * 8 + wave, NGW = G * 8;
    unsigned char* ws = a.ws;
    const float* x = a.in[0]; const float* meta = a.in[1]; const float* g_mix = a.in[2]; const float* w_in = a.in[3]; const float* b_gate = a.in[4];
    const float* pool_w = a.in[5]; const float* pool_scale = a.in[6]; const float* conv_w = a.in[7]; const float* conv_out_w = a.in[8]; const float* w_o = a.in[9];
    const float* g_ffn = a.in[10]; const float* w_gu = a.in[11]; const float* w_down = a.in[12]; const float* g_final = a.in[13];
    float* out = a.out;
    bf16_t* WdT = (bf16_t*)(ws + WS_WD); bf16_t* WguT = (bf16_t*)(ws + WS_WGU); bf16_t* WoT = (bf16_t*)(ws + WS_WO); bf16_t* Bcat = (bf16_t*)(ws + WS_BCAT); bf16_t* WinT = (bf16_t*)(ws + WS_WIN);
    bf16_t* HN = (bf16_t*)(ws + WS_HN); bf16_t* U = (bf16_t*)(ws + WS_U); bf16_t* Sb = (bf16_t*)(ws + WS_S); bf16_t* GB = (bf16_t*)(ws + WS_GB); bf16_t* GATES = (bf16_t*)(ws + WS_GATES);
    bf16_t* ACT2 = (bf16_t*)(ws + WS_ACT2); float* ZA = (float*)(ws + WS_ZA); bf16_t* Z = (bf16_t*)(ws + WS_Z); bf16_t* H1B = (bf16_t*)(ws + WS_H1B); bf16_t* ACT = (bf16_t*)(ws + WS_ACT);
    float* SSQ1 = (float*)(ws + WS_SSQ1); float* SSQ2 = (float*)(ws + WS_SSQ2);

    const int lo = a.ph_lo, hi = a.ph_hi;
    if (lo < 0) grid.sync();
    XcdBarrier xbar; xbar.bar = (unsigned*)ws; xbar.x = 0; xbar.st = nullptr;
#if MK_N_LAUNCHES == 1
    { volatile LAS unsigned* st = (volatile LAS unsigned*)(lds + LDS_BYTES - 64); if (tid < 16) st[tid] = 0u; __syncthreads(); xbar = xcd_barrier_post((unsigned*)ws, st); }
#endif
#define IN(k) (lo <= (k) && (k) < hi)
#if MK_N_LAUNCHES == 1
#define GSYNC() xcd_barrier(xbar)
#else
#define GSYNC() do {} while (0)
#endif
#define SEAM(k) do { if (IN(k) && IN((k) + 1)) GSYNC(); } while (0)

    constexpr int I_WIN = 32 * 192, I_WGU = 32 * 176, I_WO = 32 * 32, I_CO = 32 * 32, I_PW = 4 * 8 * 8, I_WD = 88 * 32;
    constexpr int IT_MID = I_WIN + I_WGU + I_WO + I_CO + I_PW, NITEMS = IT_MID + I_WD;
    constexpr int G_GEMM = 224, P0_TILES = 14;
    const bool split_conv = (G == 256) && (MK_N_LAUNCHES == 1);
#define CONVERT_ITEMS(lo_, hi_, w_, nw_, cnt_) do { int lane = tid & 63, wv_ = wave; asm volatile("" : "+v"(lane), "+s"(wv_));   \
        LAS float* scr = (LAS float*)(lds + wv_ * 16640); unsigned* const cntp_ = (cnt_); \
        for (int it = (lo_) + (w_); it < (hi_); it += (nw_)) { int r = it; \
            if (r < I_WIN) {   \
                const int t_ = r >> 7, kb = (r & 127) >> 2, sub = r & 3; \
                const int nb = t_ < 8 ? 4 * t_ + sub : (t_ < 24 ? (sub < 2 ? 64 + 2 * (t_ - 8) + sub : 96 + 2 * (t_ - 8) + (sub - 2)) : (t_ < 32 ? 32 + 4 * (t_ - 24) + sub : (sub < 2 ? 128 + 2 * (t_ - 32) + sub : 160 + 2 * (t_ - 32) + (sub - 2)))); \
                const int n0 = 64 * nb; int drow; \
                if (n0 < 2048) drow = n0; \
                else if (n0 < 4096) drow = 6144 + (n0 - 2048); \
                else if (n0 < 6144) { const int cc = n0 - 4096; drow = 2048 + 256 * (cc >> 7) + (cc & 127); } \
                else if (n0 < 8192) { const int cc = n0 - 6144; drow = 2048 + 256 * (cc >> 7) + 128 + (cc & 127); } \
                else { int cc = n0 - 8192; if (cc < 2048) drow = 8192 + 256 * (cc >> 7) + (cc & 127); else { cc -= 2048; drow = 8192 + 256 * (cc >> 7) + 128 + (cc & 127); } }   \
                tr_item(w_in, NIN, 64 * kb, n0, WinT, D, drow, 0, nullptr, nullptr, scr, lane, cntp_ != nullptr); \
                if (cntp_) { asm volatile("s_waitcnt vmcnt(0)" ::: "memory"); if (lane == 0) __hip_atomic_fetch_add(cntp_ + 32 * t_, 1u, __ATOMIC_RELAXED, __HIP_MEMORY_SCOPE_AGENT); } \
                continue; } r -= I_WIN; \
            if (r < I_WGU) { const int kb = r / 176, nb = r % 176, n0 = 64 * nb; int drow; \
                if (n0 < FF) drow = 256 * (n0 >> 7) + (n0 & 127); else { const int cc = n0 - FF; drow = 256 * (cc >> 7) + 128 + (cc & 127); } \
                tr_item(w_gu, NGU, 64 * kb, n0, WguT, D, drow, 0, g_ffn, nullptr, scr, lane); continue; } r -= I_WGU; \
            if (r < I_WO) { const int kb = r / 32, nb = r % 32; tr_item(w_o, D, 64 * kb, 64 * nb, WoT, D, 64 * nb, 0, nullptr, nullptr, scr, lane); continue; } r -= I_WO; \
            if (r < I_CO) { const int kb = r / 32, nb = r % 32; tr_item(conv_out_w, D, 64 * kb, 64 * nb, Bcat, KCAT, 64 * nb, 512, nullptr, nullptr, scr, lane); continue; } r -= I_CO; \
            if (r < I_PW) { const int g = r / 64, rr = r % 64, kb = rr / 8, nb = rr % 8; \
                tr_item(pool_w + (size_t)g * 512 * 512, 512, 64 * kb, 64 * nb, Bcat, KCAT, g * 512 + 64 * nb, 0, nullptr, pool_scale + g * 512, scr, lane); continue; } r -= I_PW; \
            { const int kb = r / 32, nb = r % 32; tr_item(w_down, D, 64 * kb, 64 * nb, WdT, FF, 64 * nb, 0, nullptr, nullptr, scr, lane); } \
        } } while (0)

    if (IN(0)) {
        CONVERT_ITEMS(0, split_conv ? P0_TILES * 128 : NITEMS, gw, NGW, nullptr);
        for (int m = gw; m < MA; m += NGW) {
            const float* src = m < MX ? x + (size_t)m * D : (m < MX + NMETA ? meta + (size_t)(m - MX) * D : nullptr);
            rms_row_to_bf16(src, g_mix, HN + (size_t)m * D, lane);
        }
    }
    SEAM(0);

    if (IN(1)) {
        unsigned* tcnt = (unsigned*)ws + 6144;
        if (!split_conv || bx < G_GEMM) {
            SchedP1 S{(const char*)HN, (const char*)WinT, split_conv ? G_GEMM : G, bx, split_conv ? tcnt : nullptr};
            EpiP1 E{U, Sb, GB, GATES, b_gate};
            pg8::gemm_phase(lds, D, D, S, E);
        } else {
            const int cw = (bx - G_GEMM) * 8 + wave, ncw = (G - G_GEMM) * 8;
            CONVERT_ITEMS(P0_TILES * 128, I_WIN, cw, ncw, tcnt);
            CONVERT_ITEMS(I_WIN, NITEMS, cw, ncw, nullptr);
        }
    }
    SEAM(1);

    if (IN(2)) {
        const int nthr = G * 512;
        for (int idx = vcu * 512 + tid; idx < (MX / 8) * 256; idx += nthr) {
            const int cgp = idx & 255, rb = idx >> 8, b = rb >> 8, t0 = (rb & 255) * 8, col = cgp * 8;
            const int grp = col >> 9;
            if (grp == 0) pool_task<2>(U, ACT2, b, t0, col); else if (grp == 1) pool_task<4>(U, ACT2, b, t0, col); else if (grp == 2) pool_task<8>(U, ACT2, b, t0, col); else pool_task<16>(U, ACT2, b, t0, col);
            conv_task(Sb, GB, conv_w, ACT2, b, t0, col);
        }
    }
    SEAM(2);

    if (IN(3)) {
        SchedP3 S{(const char*)ACT2, (const char*)Bcat, G, bx};
        EpiP3 E{GATES, Z};
        pg8::gemm_phase(lds, 4096, KCAT, S, E);
    }
    SEAM(3);

    if (IN(4)) {
        SchedG S{(const char*)Z, (const char*)WoT, G, bx, 32, 8, D};
        EpiP4 E{x, H1B, SSQ1};
        pg8::gemm_phase(lds, D, D, S, E);
    }
    SEAM(4);

    if (IN(5)) {
        EpiP5 E{SSQ1, ACT};
        { SchedP5a S{(const char*)H1B, (const char*)WguT, G, bx}; pg8::gemm_phase(lds, D, D, S, E); }
        if (G == 256) { SchedP5b S2{(const char*)H1B, (const char*)WguT, bx}; pg8::gemm_phase<true>(lds, D, D, S2, E); }
        if (!split_conv && bx >= 128) CONVERT_ITEMS(IT_MID, NITEMS, (bx - 128) * 8 + wave, (G - 128) * 8, nullptr);
    }
    SEAM(5);

    if (IN(6)) {
        SchedG S{(const char*)ACT, (const char*)WdT, G, bx, 32, 8, FF};
        EpiP6F E{H1B, out, g_final, (unsigned*)(ws + WS_SSQ2), (unsigned*)ws + 4096};
        pg8::gemm_phase(lds, FF, FF, S, E);
    }
#undef IN
#undef SEAM
}

extern "C" void kernel_launch(void* const* d_in, const int* in_sizes, int n_in, void* d_out, int out_size, void* d_ws, size_t ws_size, hipStream_t stream) {
    static int grid = 0;
    if (grid == 0) {
        if (n_in != 14 || out_size != MX * D || ws_size < WS_END) { fprintf(stderr, "kernel_launch: unexpected shapes (n_in %d out %d ws %zu)\n", n_in, out_size, ws_size); grid = -1; return; }
        int dev = 0, cus = 0, per_cu = 0;
        if (hipGetDevice(&dev) != hipSuccess || hipDeviceGetAttribute(&cus, hipDeviceAttributeMultiprocessorCount, dev) != hipSuccess) { grid = -1; return; }
        if (hipFuncSetAttribute((const void*)fwd_megakernel, hipFuncAttributeMaxDynamicSharedMemorySize, LDS_BYTES) != hipSuccess) { fprintf(stderr, "kernel_launch: hipFuncSetAttribute failed\n"); grid = -1; return; }
        if (hipOccupancyMaxActiveBlocksPerMultiprocessor(&per_cu, (const void*)fwd_megakernel, 512, LDS_BYTES) != hipSuccess || per_cu < 1) { fprintf(stderr, "kernel_launch: occupancy query says %d blocks per CU\n", per_cu); per_cu = 1; }
        (void)hipGetLastError();
        if (cus != 256) { fprintf(stderr, "kernel_launch: built for a 256-CU device (got %d)\n", cus); grid = -1; return; }
        grid = cus;
    }
    if (grid < 0) return;
    if (hipMemsetAsync(d_ws, 0, 32768, stream) != hipSuccess) { fprintf(stderr, "kernel_launch: memset failed\n"); return; }
    Args a{};
    for (int i = 0; i < 14; ++i) a.in[i] = (const float*)d_in[i];
    a.out = (float*)d_out; a.ws = (unsigned char*)d_ws;
#if MK_N_LAUNCHES == 1
    a.ph_lo = 0; a.ph_hi = N_PHASES;
    void* args[] = {&a};
    hipError_t e = hipLaunchCooperativeKernel((const void*)fwd_megakernel, dim3(grid), dim3(512), args, LDS_BYTES, stream);
    if (e != hipSuccess) fprintf(stderr, "kernel_launch: cooperative launch failed: %s (grid %d)\n", hipGetErrorString(e), grid);
#else
    for (int p = 0; p < N_PHASES; ++p) { a.ph_lo = p; a.ph_hi = p + 1; hipLaunchKernelGGL(fwd_megakernel, dim3(grid), dim3(512), LDS_BYTES, stream, a); }
#endif
}
```
